# Optimizing an MI355X kernel written in HIP

```python
import jax, jax.numpy as jnp
from jax import lax
import numpy as np

D_MODEL = 1024
BATCH = 4
SEQ = 8192
DEPTH = 2

N_HEADS = 16
N_KV_HEADS = 4
HEAD_DIM = 64
GROUP = N_HEADS // N_KV_HEADS
Q_BLOCK = 128
ROPE_THETA = 10000.0
ROPE_HALF = HEAD_DIM // 2
GRID_W = 64
D_RNN = 1024
N_RNN_BLOCKS = 16
RNN_BLOCK = D_RNN // N_RNN_BLOCKS
CONV_W = 4
CONV_PAD = (2, 1)
LRU_C = 8.0
D_FF = 2816
FFN_RESID = 0.5
N_BRANCH = 2
EPS = 1e-6
Q_COLS = N_HEADS * HEAD_DIM
KV_COLS = N_KV_HEADS * HEAD_DIM
IN_COLS = Q_COLS + 2 * KV_COLS + 2 * D_RNN + N_BRANCH * D_MODEL
SPLITS = (Q_COLS, Q_COLS + KV_COLS, Q_COLS + 2 * KV_COLS,
          Q_COLS + 2 * KV_COLS + D_RNN, Q_COLS + 2 * KV_COLS + 2 * D_RNN)

kernel_name = "griffin_gated_gqa_rglru_macaron_encoder"


def rmsnorm(x, g):
    xf = x.astype(jnp.float32)
    y = xf * lax.rsqrt(jnp.mean(xf * xf, axis=-1, keepdims=True) + EPS)
    return (y * g.astype(jnp.float32)).astype(x.dtype)


def swiglu(x, w1, w2):
    gu = x @ w1
    g, u = jnp.split(gu, 2, axis=-1)
    return (jax.nn.silu(g) * u) @ w2


def rope_tables(seq):
    rows = seq // GRID_W
    row = jnp.repeat(jnp.arange(rows, dtype=jnp.int32), GRID_W).astype(jnp.float32)
    col = jnp.tile(jnp.arange(GRID_W, dtype=jnp.int32), rows).astype(jnp.float32)
    inv = ROPE_THETA ** (-jnp.arange(0, ROPE_HALF, 2, dtype=jnp.float32) / ROPE_HALF)
    ang_r = row[:, None] * inv[None, :]
    ang_c = col[:, None] * inv[None, :]
    return (jnp.cos(ang_r)[:, None], jnp.sin(ang_r)[:, None],
            jnp.cos(ang_c)[:, None], jnp.sin(ang_c)[:, None])


def apply_rope(x, tabs):
    cr, sr, cc, sc = tabs
    xf = x.astype(jnp.float32)
    r1, r2, c1, c2 = jnp.split(xf, 4, axis=-1)
    out = jnp.concatenate([r1 * cr - r2 * sr, r2 * cr + r1 * sr,
                           c1 * cc - c2 * sc, c2 * cc + c1 * sc], axis=-1)
    return out.astype(x.dtype)


def block_attention(q, k, v):
    b, s = q.shape[0], q.shape[1]
    nb = s // Q_BLOCK
    scale = HEAD_DIM ** -0.5
    qb = (q * scale).reshape(b, nb, Q_BLOCK, N_KV_HEADS, GROUP, HEAD_DIM).transpose(1, 0, 2, 3, 4, 5)

    def one_block(qi):
        sc = jnp.einsum('bqhgd,bkhd->bhgqk', qi, k).astype(jnp.float32)
        p = jax.nn.softmax(sc, axis=-1)
        return jnp.einsum('bhgqk,bkhd->bqhgd', p.astype(v.dtype), v)

    o = lax.map(one_block, qb)
    return o.transpose(1, 0, 2, 3, 4, 5).reshape(b, s, Q_COLS)


def depthwise_conv(x, w, bias):
    y = lax.conv_general_dilated(x, w[:, None, :], window_strides=(1,), padding=[CONV_PAD],
                                 dimension_numbers=('NWC', 'WIO', 'NWC'),
                                 feature_group_count=D_RNN)
    return y + bias


def _lin_combine(c1, c2):
    a1, b1 = c1
    a2, b2 = c2
    return a1 * a2, a2 * b1 + b2


def rg_lru(x, wa, ba, wx, bx, lam, reverse):
    b, s, _ = x.shape
    xb = x.reshape(b, s, N_RNN_BLOCKS, RNN_BLOCK)
    r = jax.nn.sigmoid((jnp.einsum('bsnc,ncd->bsnd', xb, wa).reshape(b, s, D_RNN) + ba).astype(jnp.float32))
    i = jax.nn.sigmoid((jnp.einsum('bsnc,ncd->bsnd', xb, wx).reshape(b, s, D_RNN) + bx).astype(jnp.float32))
    log_a = -LRU_C * r * jax.nn.softplus(-lam.astype(jnp.float32))
    a = jnp.exp(log_a)
    u = jnp.sqrt(-jnp.expm1(2.0 * log_a)) * (i * x.astype(jnp.float32))
    _, h = lax.associative_scan(_lin_combine, (a, u), axis=1, reverse=reverse)
    return h


def setup_inputs(seed: int = 0) -> dict:
    key = jax.random.key(seed)
    ks = jax.random.split(key, 24)
    f32 = jnp.float32

    def nrm(k, shape, scale):
        return jax.random.normal(k, shape, f32) * scale

    def gain(k, shape):
        return 1.0 + 0.02 * jax.random.normal(k, shape, f32)

    L = DEPTH
    u = jax.random.uniform(ks[16], (L, 2, D_RNN), f32, 0.9, 0.999)
    p = u ** (1.0 / LRU_C)
    lam = jnp.log(p) - jnp.log1p(-p)
    return {
        "x": jax.random.normal(ks[0], (BATCH, SEQ, D_MODEL), f32),
        "ffn1_norm": gain(ks[1], (L, D_MODEL)),
        "ffn1_w1": nrm(ks[2], (L, D_MODEL, 2 * D_FF), D_MODEL ** -0.5),
        "ffn1_w2": nrm(ks[3], (L, D_FF, D_MODEL), D_FF ** -0.5),
        "mix_norm": gain(ks[4], (L, D_MODEL)),
        "w_in": nrm(ks[5], (L, D_MODEL, IN_COLS), D_MODEL ** -0.5),
        "b_gate": nrm(ks[6], (L, N_BRANCH, D_MODEL), 0.01),
        "q_norm": gain(ks[7], (L, HEAD_DIM)),
        "k_norm": gain(ks[8], (L, HEAD_DIM)),
        "w_attn_o": nrm(ks[9], (L, Q_COLS, D_MODEL), Q_COLS ** -0.5),
        "conv_w": nrm(ks[10], (L, CONV_W, D_RNN), CONV_W ** -0.5),
        "conv_b": nrm(ks[11], (L, D_RNN), 0.01),
        "lru_wa": nrm(ks[12], (L, 2, N_RNN_BLOCKS, RNN_BLOCK, RNN_BLOCK), RNN_BLOCK ** -0.5),
        "lru_ba": nrm(ks[13], (L, 2, D_RNN), 0.01),
        "lru_wx": nrm(ks[14], (L, 2, N_RNN_BLOCKS, RNN_BLOCK, RNN_BLOCK), RNN_BLOCK ** -0.5),
        "lru_bx": nrm(ks[15], (L, 2, D_RNN), 0.01),
        "lru_lambda": lam,
        "w_rnn_o": nrm(ks[17], (L, D_RNN, D_MODEL), D_RNN ** -0.5),
        "w_out": nrm(ks[18], (L, D_MODEL, D_MODEL), D_MODEL ** -0.5),
        "ffn2_norm": gain(ks[19], (L, D_MODEL)),
        "ffn2_w1": nrm(ks[20], (L, D_MODEL, 2 * D_FF), D_MODEL ** -0.5),
        "ffn2_w2": nrm(ks[21], (L, D_FF, D_MODEL), D_FF ** -0.5),
    }


def reference(x, ffn1_norm, ffn1_w1, ffn1_w2, mix_norm, w_in, b_gate, q_norm, k_norm,
              w_attn_o, conv_w, conv_b, lru_wa, lru_ba, lru_wx, lru_bx, lru_lambda,
              w_rnn_o, w_out, ffn2_norm, ffn2_w1, ffn2_w2):
    b, s, _ = x.shape
    tabs = rope_tables(s)
    for l in range(DEPTH):
        x = x + FFN_RESID * swiglu(rmsnorm(x, ffn1_norm[l]), ffn1_w1[l], ffn1_w2[l])

        h = rmsnorm(x, mix_norm[l])
        proj = h @ w_in[l]
        q, k, v, xr, yr, gl = jnp.split(proj, SPLITS, axis=-1)

        q = apply_rope(rmsnorm(q.reshape(b, s, N_HEADS, HEAD_DIM), q_norm[l]), tabs)
        k = apply_rope(rmsnorm(k.reshape(b, s, N_KV_HEADS, HEAD_DIM), k_norm[l]), tabs)
        v = v.reshape(b, s, N_KV_HEADS, HEAD_DIM)
        attn = block_attention(q, k, v) @ w_attn_o[l]

        xc = depthwise_conv(xr, conv_w[l], conv_b[l])
        hr = (rg_lru(xc, lru_wa[l, 0], lru_ba[l, 0], lru_wx[l, 0], lru_bx[l, 0], lru_lambda[l, 0], False)
              + rg_lru(xc, lru_wa[l, 1], lru_ba[l, 1], lru_wx[l, 1], lru_bx[l, 1], lru_lambda[l, 1], True))
        rnn = (hr.astype(x.dtype) * jax.nn.gelu(yr)) @ w_rnn_o[l]

        gates = jax.nn.sigmoid(gl.reshape(b, s, N_BRANCH, D_MODEL) + b_gate[l])
        merged = gates[:, :, 0] * attn + gates[:, :, 1] * rnn
        x = x + merged @ w_out[l]

        x = x + FFN_RESID * swiglu(rmsnorm(x, ffn2_norm[l]), ffn2_w1[l], ffn2_w2[l])
    return x
```

```cpp
#include <hip/hip_runtime.h>
#include <cstdio>
#include <cstdint>

__device__ __forceinline__ int otid() { int t = threadIdx.x; asm volatile("" : "+v"(t)); return t; }
namespace pg8 {
#define PG8_LAS __attribute__((address_space(3)))
typedef unsigned short bf16_t;
typedef short bf16x8 __attribute__((ext_vector_type(8)));
typedef float f32x4 __attribute__((ext_vector_type(4)));
typedef unsigned u32x4 __attribute__((ext_vector_type(4)));
constexpr int BM = 256, BK = 64, HALF = 128, HTB = HALF * BK * 2  , STAGE_BYTES = 8 * HTB, NXCD = 8, WGM = 8;

__host__ __device__ __forceinline__ int lds_byte(int r, int c) { const int st = (r >> 4) * 2 + (c >> 5), rr = r & 15, cc = c & 31, ob = rr * 64 + cc * 2; return st * 1024 + (ob ^ (((ob >> 9) & 1) << 5)); }
__host__ __device__ __forceinline__ void stage_rc(int b, int& R, int& C) { const int st = b / 1024, sb = b % 1024, swz = sb ^ (((sb >> 9) & 1) << 5); R = (st >> 1) * 16 + swz / 64; C = (st & 1) * 32 + (swz % 64) / 2; }
__host__ __device__ __forceinline__ int perm32(int rho) { const int n = rho >> 4, i = rho & 15; return 8 * (i >> 2) + 4 * n + (i & 3); }

struct Unit { int pm, pn; };
struct Gemm { const bf16_t* A; const bf16_t* Bt; int M, N, K; };

struct StaticOrder {
    int nM, nN, nwg, G, c;
    __host__ __device__ void init(int M, int N, int G_, int c_) { nM = M / BM; nN = N / BM; nwg = nM * nN; G = G_; c = c_; }
    __host__ __device__ bool next(int i, Unit& u) const {
        const long L = (long)i * G + c; if (L >= nwg) return false;
        int wgid = (int)L; { const int q = nwg / NXCD, r = nwg % NXCD, xcd = wgid % NXCD, off = wgid / NXCD; wgid = (xcd < r ? xcd * (q + 1) : r * (q + 1) + (xcd - r) * q) + off; }
        const int nig = WGM * nN, gid = wgid / nig, fm = gid * WGM, gsz = (nM - fm) < WGM ? (nM - fm) : WGM;
        u.pm = fm + ((wgid % nig) % gsz); u.pn = (wgid % nig) / gsz; return true;
    }
    __device__ __forceinline__ void a_ready(const Unit&) const {}
    __device__ __forceinline__ void done(const Unit&) const {}
};


__device__ __forceinline__ unsigned cvt_pk_bf16(float lo, float hi) { unsigned r; asm volatile("v_cvt_pk_bf16_f32 %0, %1, %2" : "=v"(r) : "v"(lo), "v"(hi)); return r; }
__device__ __forceinline__ float bf_lo(unsigned w) { return __uint_as_float(w << 16); }
__device__ __forceinline__ float bf_hi(unsigned w) { return __uint_as_float(w & 0xffff0000u); }
__device__ __forceinline__ float fsigmoid(float x) { return __builtin_amdgcn_rcpf(1.f + __expf(-x)); }
__device__ __forceinline__ float gelu_tanh(float x) { const float z2 = 1.5957691216f * (x + 0.044715f * x * x * x); return x * fsigmoid(z2); }
constexpr float RMS_EPS = 1e-6f;
__device__ __forceinline__ float row_rstd(const float* rowss, int row) { const f32x4* p = (const f32x4*)(rowss + (size_t)row * 16); const f32x4 a = p[0], b = p[1], c = p[2], d = p[3];
    const float s = ((a[0] + a[1]) + (a[2] + a[3])) + ((b[0] + b[1]) + (b[2] + b[3])) + ((c[0] + c[1]) + (c[2] + c[3])) + ((d[0] + d[1]) + (d[2] + d[3])); return __builtin_amdgcn_rsqf(s * (1.0f / 1024.0f) + RMS_EPS); }

struct EpiSwiglu {
    static constexpr bool PERM = true, AFTER_DRAIN = false;
    bf16_t* H; const float* rowss; int ldh;
    __device__ __forceinline__ void operator()(const f32x4 (&acc)[2][2][4][2], const Unit& u, int wr, int wc, int fr, int fq) const {
        const int row0 = u.pm * BM + wr * 64 + fr, col0 = u.pn * HALF + wc * 32 + 8 * fq;
#pragma unroll
        for (int ai = 0; ai < 2; ++ai)
#pragma unroll
            for (int m = 0; m < 4; ++m) { const int row = row0 + ai * HALF + m * 16; const float rs = row_rstd(rowss, row), c1 = rs * -1.4426950408889634f, rs2 = rs * rs;
                float h[8];
#pragma unroll
                for (int n = 0; n < 2; ++n)
#pragma unroll
                    for (int e = 0; e < 4; ++e) { const float ag = acc[ai][0][m][n][e], au = acc[ai][1][m][n][e];
                        h[4 * n + e] = (ag * au) * (rs2 * __builtin_amdgcn_rcpf(1.0f + __builtin_amdgcn_exp2f(ag * c1))); }
                u32x4 w; w.x = cvt_pk_bf16(h[0], h[1]); w.y = cvt_pk_bf16(h[2], h[3]); w.z = cvt_pk_bf16(h[4], h[5]); w.w = cvt_pk_bf16(h[6], h[7]);
                *(u32x4*)(H + (((size_t)u.pm * (ldh / 64) + (col0 >> 6)) * 256 + (row & 255)) * 64 + (col0 & 63)) = w; }
    }
};
struct EpiResid {
    static constexpr bool PERM = true, AFTER_DRAIN = false;
    bf16_t* xb; float* out; float* rowss; float scale;
    __device__ __forceinline__ void operator()(const f32x4 (&acc)[2][2][4][2], const Unit& u, int wr, int wc, int fr, int fq) const {
        const int row0 = u.pm * BM + wr * 64 + fr, col0 = u.pn * BM + wc * 32 + 8 * fq;
#pragma unroll
        for (int ai = 0; ai < 2; ++ai) {
            u32x4 bs[4][2];
#pragma unroll
            for (int m = 0; m < 4; ++m) { const size_t off = (size_t)(row0 + ai * HALF + m * 16) * 1024 + col0;
#pragma unroll
                for (int bj = 0; bj < 2; ++bj) bs[m][bj] = *(const u32x4*)(xb + off + bj * HALF); }
#pragma unroll
            for (int m = 0; m < 4; ++m) { const int row = row0 + ai * HALF + m * 16; const size_t off = (size_t)row * 1024 + col0; float s = 0.f;
#pragma unroll
                for (int bj = 0; bj < 2; ++bj) { const u32x4 b4 = bs[m][bj]; const f32x4 a0 = acc[ai][bj][m][0] * scale, a1 = acc[ai][bj][m][1] * scale;
                    float o[8];
                    o[0] = bf_lo(b4.x) + a0[0]; o[1] = bf_hi(b4.x) + a0[1]; o[2] = bf_lo(b4.y) + a0[2]; o[3] = bf_hi(b4.y) + a0[3];
                    o[4] = bf_lo(b4.z) + a1[0]; o[5] = bf_hi(b4.z) + a1[1]; o[6] = bf_lo(b4.w) + a1[2]; o[7] = bf_hi(b4.w) + a1[3];
                    s += ((o[0] * o[0] + o[1] * o[1]) + (o[2] * o[2] + o[3] * o[3])) + ((o[4] * o[4] + o[5] * o[5]) + (o[6] * o[6] + o[7] * o[7]));
                    if (out) { *(f32x4*)(out + off + bj * HALF) = (f32x4){o[0], o[1], o[2], o[3]}; *(f32x4*)(out + off + bj * HALF + 4) = (f32x4){o[4], o[5], o[6], o[7]}; }
                    else { u32x4 w; w.x = cvt_pk_bf16(o[0], o[1]); w.y = cvt_pk_bf16(o[2], o[3]); w.z = cvt_pk_bf16(o[4], o[5]); w.w = cvt_pk_bf16(o[6], o[7]); *(u32x4*)(xb + off + bj * HALF) = w; } }
                if (rowss) { s += __shfl_xor(s, 16); s += __shfl_xor(s, 32); if (fq == 0) rowss[(size_t)row * 16 + u.pn * 4 + wc] = s; } }
        }
    }
};
struct EpiIn {
    static constexpr bool PERM = true, AFTER_DRAIN = false;
    bf16_t *q, *k, *v, *xr, *yr, *gl; const float* rowss; const float* bgate;
    __device__ __forceinline__ void operator()(const f32x4 (&acc)[2][2][4][2], const Unit& u, int wr, int wc, int fr, int fq) const {
        const int pn = u.pn; bf16_t* base; int ldc, colt, mode = 0;
        if (pn < 4) { base = q; ldc = 1024; colt = 256 * pn; }
        else if (pn == 4) { base = k; ldc = 256; colt = 0; mode = 3; }
        else if (pn == 5) { base = v; ldc = 256; colt = 0; mode = 4; }
        else if (pn < 10) { base = xr; ldc = 1024; colt = 256 * (pn - 6); }
        else if (pn < 14) { base = yr; ldc = 1024; colt = 256 * (pn - 10); mode = 1; }
        else { base = gl; ldc = 2048; colt = 256 * (pn - 14); mode = 2; }
        const int row0 = u.pm * BM + wr * 64 + fr, col0 = colt + wc * 32 + 8 * fq;
        f32x4 bv[2][2];
#pragma unroll
        for (int bj = 0; bj < 2; ++bj)
#pragma unroll
            for (int n = 0; n < 2; ++n) bv[bj][n] = (mode == 2) ? *(const f32x4*)(bgate + col0 + bj * HALF + 4 * n) : (f32x4){0.f, 0.f, 0.f, 0.f};
#pragma unroll
        for (int ai = 0; ai < 2; ++ai)
#pragma unroll
            for (int m = 0; m < 4; ++m) { const int row = row0 + ai * HALF + m * 16; const float rs = row_rstd(rowss, row); bf16_t* rowp = base + (size_t)row * ldc + col0;
#pragma unroll
                for (int bj = 0; bj < 2; ++bj) { float h[8];
#pragma unroll
                    for (int n = 0; n < 2; ++n)
#pragma unroll
                        for (int e = 0; e < 4; ++e) { float t = acc[ai][bj][m][n][e] * rs; if (mode == 1) t = gelu_tanh(t); else if (mode == 2) t = fsigmoid(t + bv[bj][n][e]); h[4 * n + e] = t; }
                    u32x4 w; w.x = cvt_pk_bf16(h[0], h[1]); w.y = cvt_pk_bf16(h[2], h[3]); w.z = cvt_pk_bf16(h[4], h[5]); w.w = cvt_pk_bf16(h[6], h[7]);
                    if (mode >= 3) {
                        const int col = col0 + bj * HALF, kvh = col >> 6, d0 = col & 63, bb = row >> 13, sq = row & 8191, tt = sq >> 6, rr = sq & 63;
                        const size_t tb = ((size_t)(bb * 4 + kvh) * 128 + tt) * 4096;
                        *(u32x4*)(base + tb + (mode == 3 ? (size_t)((d0 >> 3) * 512 + rr * 8) : (size_t)((d0 >> 5) * 2048 + rr * 32 + (d0 & 31)))) = w;
                    } else *(u32x4*)(rowp + bj * HALF) = w; } }
    }
};
template <bool ACCUM> struct EpiGate {
    static constexpr bool PERM = true, AFTER_DRAIN = false;
    bf16_t* O; const bf16_t* gl; int goff;
    __device__ __forceinline__ void operator()(const f32x4 (&acc)[2][2][4][2], const Unit& u, int wr, int wc, int fr, int fq) const {
        const int row0 = u.pm * BM + wr * 64 + fr, col0 = u.pn * BM + wc * 32 + 8 * fq;
#pragma unroll
        for (int ai = 0; ai < 2; ++ai)
#pragma unroll
            for (int m = 0; m < 4; ++m) { const int row = row0 + ai * HALF + m * 16;
#pragma unroll
                for (int bj = 0; bj < 2; ++bj) { const int col = col0 + bj * HALF;
                    const u32x4 g = *(const u32x4*)(gl + (size_t)row * 2048 + goff + col); bf16_t* op = O + (size_t)row * 1024 + col;
                    u32x4 pv = (u32x4){0u, 0u, 0u, 0u}; if (ACCUM) pv = *(const u32x4*)op;
                    const f32x4 a0 = acc[ai][bj][m][0], a1 = acc[ai][bj][m][1];
                    float h[8];
                    h[0] = bf_lo(g.x) * a0[0]; h[1] = bf_hi(g.x) * a0[1]; h[2] = bf_lo(g.y) * a0[2]; h[3] = bf_hi(g.y) * a0[3];
                    h[4] = bf_lo(g.z) * a1[0]; h[5] = bf_hi(g.z) * a1[1]; h[6] = bf_lo(g.w) * a1[2]; h[7] = bf_hi(g.w) * a1[3];
                    if (ACCUM) { h[0] += bf_lo(pv.x); h[1] += bf_hi(pv.x); h[2] += bf_lo(pv.y); h[3] += bf_hi(pv.y); h[4] += bf_lo(pv.z); h[5] += bf_hi(pv.z); h[6] += bf_lo(pv.w); h[7] += bf_hi(pv.w); }
                    u32x4 w; w.x = cvt_pk_bf16(h[0], h[1]); w.y = cvt_pk_bf16(h[2], h[3]); w.z = cvt_pk_bf16(h[4], h[5]); w.w = cvt_pk_bf16(h[6], h[7]);
                    *(u32x4*)op = w; } }
    }
};

template <class Epi, class Sched, bool ALIGN_EPI = false, bool SP2 = false, bool ATILED = false>
__device__ __forceinline__ void gemm_phase(PG8_LAS unsigned char* lds, const Gemm g, const Sched& S, const Epi& E) {
    const int tid = otid(), wid = __builtin_amdgcn_readfirstlane(tid >> 6), lane = tid & 63, wr = wid >> 2, wc = wid & 3, fr = lane & 15, fq = lane >> 4;
    const int K = g.K, nt = K / BK;
    unsigned voffA[2], voffB[2];
#pragma unroll
    for (int i = 0; i < 2; ++i) { int R, C; stage_rc(tid * 16 + i * 8192, R, C); const int Rb = Epi::PERM ? ((R & ~31) + perm32(R & 31)) : R;
        voffA[i] = ATILED ? (unsigned)(R * 64 + C) * 2u : (unsigned)(R * K + C) * 2u; voffB[i] = (unsigned)(Rb * K + C) * 2u; }
    const size_t kstep = (size_t)(BK * 2);
    const size_t hstep = (size_t)HALF * K * 2;
    const size_t tstep = 2 * hstep;
    const size_t kstepA = ATILED ? (size_t)32768 : kstep, hstepA = ATILED ? (size_t)16384 : hstep, tstepA = ATILED ? (size_t)(K / BK) * 32768 : tstep;
    const unsigned ldsw = (unsigned)wid * 1024u;
    const int aoff = lds_byte(wr * 64 + fr, fq * 8), boff = lds_byte(wc * 32 + fr, fq * 8);
#define PG8_SA(b, h) (((b) * 2 + (h)) * HTB)
#define PG8_SB(b, h) ((4 + (b) * 2 + (h)) * HTB)
#define PG8_STAGE(bufoff, gbase, voff) do { _Pragma("unroll") for (int _i = 0; _i < 2; ++_i) \
        __builtin_amdgcn_global_load_lds((const unsigned*)((const char*)(gbase) + (voff)[_i]), (PG8_LAS unsigned*)(lds + (bufoff) + ldsw + _i * 8192), 16, 0, 0); } while (0)
#define PG8_LDA(dst, b, h) do { _Pragma("unroll") for (int m = 0; m < 4; ++m) _Pragma("unroll") for (int k = 0; k < 2; ++k) dst[m][k] = *(const PG8_LAS bf16x8*)(lds + PG8_SA(b, h) + aoff + m * 2048 + k * 1024); } while (0)
#define PG8_LDB(dst, b, h) do { _Pragma("unroll") for (int n = 0; n < 2; ++n) _Pragma("unroll") for (int k = 0; k < 2; ++k) dst[n][k] = *(const PG8_LAS bf16x8*)(lds + PG8_SB(b, h) + boff + n * 2048 + k * 1024); } while (0)
#define PG8_MMA(ai, bj, At, Bt) do { __builtin_amdgcn_s_setprio(1); _Pragma("unroll") for (int m = 0; m < 4; ++m) _Pragma("unroll") for (int n = 0; n < 2; ++n) _Pragma("unroll") for (int k = 0; k < 2; ++k) \
        acc[ai][bj][m][n] = __builtin_amdgcn_mfma_f32_16x16x32_bf16(Bt[n][k], At[m][k], acc[ai][bj][m][n], 0, 0, 0); __builtin_amdgcn_s_setprio(0); } while (0)
#define PG8_WAIT_V(n) asm volatile("s_waitcnt vmcnt(" #n ")" ::: "memory")
#define PG8_WAIT_L(n) asm volatile("s_waitcnt lgkmcnt(" #n ")" ::: "memory")
#define PG8_BAR __builtin_amdgcn_s_barrier()
#define PG8_SCHED __builtin_amdgcn_sched_barrier(0)
    Unit cur, nxt; int ui = 0;
    if (!S.next(0, cur)) return;
    f32x4 acc[2][2][4][2];
#pragma unroll
    for (int a = 0; a < 2; ++a)
#pragma unroll
        for (int b = 0; b < 2; ++b)
#pragma unroll
            for (int m = 0; m < 4; ++m)
#pragma unroll
                for (int n = 0; n < 2; ++n) acc[a][b][m][n] = (f32x4){0.f, 0.f, 0.f, 0.f};
    bf16x8 At[4][2], B0[2][2], B1[2][2];
    const char* cA = (const char*)g.A + (size_t)cur.pm * tstepA; const char* cB = (const char*)g.Bt + (size_t)cur.pn * tstep;
    S.a_ready(cur);
    if constexpr (SP2) {
        PG8_STAGE(PG8_SB(0, 0), cB, voffB); PG8_STAGE(PG8_SB(0, 1), cB + hstep, voffB); PG8_STAGE(PG8_SA(0, 0), cA, voffA); PG8_STAGE(PG8_SA(0, 1), cA + hstepA, voffA);
        if (wr == 1) PG8_BAR;
        PG8_WAIT_V(2); PG8_BAR;
        PG8_STAGE(PG8_SB(1, 0), cB + kstep, voffB); PG8_STAGE(PG8_SA(1, 0), cA + kstepA, voffA); PG8_STAGE(PG8_SB(1, 1), cB + hstep + kstep, voffB);
        PG8_WAIT_V(6); PG8_BAR;
    } else {
        PG8_STAGE(PG8_SB(0, 0), cB, voffB); PG8_STAGE(PG8_SA(0, 0), cA, voffA); PG8_STAGE(PG8_SB(0, 1), cB + hstep, voffB); PG8_STAGE(PG8_SA(0, 1), cA + hstepA, voffA);
        if (wr == 1) PG8_BAR;
        PG8_WAIT_V(4); PG8_BAR;
        PG8_STAGE(PG8_SB(1, 0), cB + kstep, voffB); PG8_STAGE(PG8_SA(1, 0), cA + kstepA, voffA); PG8_STAGE(PG8_SB(1, 1), cB + hstep + kstep, voffB);
        PG8_WAIT_V(6); PG8_BAR;
    }
    for (;;) {
        const bool has_next = S.next(ui + 1, nxt);
        const char* nA = has_next ? (const char*)g.A + (size_t)nxt.pm * tstepA : cA; const char* nB = has_next ? (const char*)g.Bt + (size_t)nxt.pn * tstep : cB;
        for (int t = 0; t < nt; t += 2) {
            const bool last = (t == nt - 2);
            const char* a1 = cA + (size_t)(t + 1) * kstepA;
            const char* a2 = last ? nA : cA + (size_t)(t + 2) * kstepA; const char* b2 = last ? nB : cB + (size_t)(t + 2) * kstep;
            const char* a3 = a2 + kstepA; const char* b3 = b2 + kstep;
            if (last && has_next) S.a_ready(nxt);
            if constexpr (SP2) {
            PG8_LDB(B0, 0, 0); PG8_LDB(B1, 0, 1); PG8_SCHED; PG8_LDA(At, 0, 0); PG8_STAGE(PG8_SA(1, 1), a1 + hstepA, voffA);
            PG8_WAIT_V(8); PG8_WAIT_L(0); PG8_BAR; PG8_MMA(0, 0, At, B0); PG8_MMA(0, 1, At, B1); PG8_BAR; PG8_SCHED;
            PG8_LDA(At, 0, 1); PG8_STAGE(PG8_SB(0, 0), b2, voffB); PG8_STAGE(PG8_SB(0, 1), b2 + hstep, voffB); PG8_STAGE(PG8_SA(0, 0), a2, voffA);
            PG8_WAIT_V(8); PG8_WAIT_L(0); PG8_BAR; PG8_MMA(1, 0, At, B0); PG8_MMA(1, 1, At, B1); PG8_BAR; PG8_SCHED;
            PG8_LDB(B0, 1, 0); PG8_LDB(B1, 1, 1); PG8_SCHED; PG8_LDA(At, 1, 0); PG8_STAGE(PG8_SA(0, 1), a2 + hstepA, voffA);
            PG8_WAIT_V(8); PG8_WAIT_L(0); PG8_BAR; PG8_MMA(0, 0, At, B0); PG8_MMA(0, 1, At, B1); PG8_BAR; PG8_SCHED;
            PG8_LDA(At, 1, 1); PG8_STAGE(PG8_SB(1, 0), b3, voffB); PG8_STAGE(PG8_SB(1, 1), b3 + hstep, voffB); PG8_STAGE(PG8_SA(1, 0), a3, voffA);
            PG8_WAIT_V(8); PG8_WAIT_L(0); PG8_BAR; PG8_MMA(1, 0, At, B0); PG8_MMA(1, 1, At, B1); PG8_BAR; PG8_SCHED;
            } else {
            PG8_LDB(B0, 0, 0); PG8_SCHED; PG8_LDA(At, 0, 0); PG8_STAGE(PG8_SA(1, 1), a1 + hstepA, voffA);
            PG8_WAIT_L(8); PG8_BAR; PG8_WAIT_L(0); PG8_MMA(0, 0, At, B0); PG8_BAR; PG8_SCHED;
            PG8_LDB(B1, 0, 1); PG8_STAGE(PG8_SB(0, 0), b2, voffB);
            PG8_BAR; PG8_WAIT_L(0); PG8_MMA(0, 1, At, B1); PG8_BAR;
            PG8_LDA(At, 0, 1); PG8_STAGE(PG8_SA(0, 0), a2, voffA);
            PG8_BAR; PG8_WAIT_L(0); PG8_MMA(1, 0, At, B0); PG8_BAR; PG8_SCHED;
            PG8_STAGE(PG8_SB(0, 1), b2 + hstep, voffB);
            PG8_WAIT_V(6); PG8_BAR; PG8_MMA(1, 1, At, B1); PG8_BAR;
            PG8_LDB(B0, 1, 0); PG8_SCHED; PG8_LDA(At, 1, 0); PG8_STAGE(PG8_SA(0, 1), a2 + hstepA, voffA);
            PG8_WAIT_L(8); PG8_BAR; PG8_WAIT_L(0); PG8_MMA(0, 0, At, B0); PG8_BAR; PG8_SCHED;
            PG8_LDB(B1, 1, 1); PG8_STAGE(PG8_SB(1, 0), b3, voffB);
            PG8_BAR; PG8_WAIT_L(0); PG8_MMA(0, 1, At, B1); PG8_BAR;
            PG8_LDA(At, 1, 1); PG8_STAGE(PG8_SA(1, 0), a3, voffA);
            PG8_BAR; PG8_WAIT_L(0); PG8_MMA(1, 0, At, B0); PG8_BAR; PG8_SCHED;
            PG8_STAGE(PG8_SB(1, 1), b3 + hstep, voffB);
            PG8_WAIT_V(6); PG8_BAR; PG8_MMA(1, 1, At, B1); PG8_BAR;
            }
        }
        if constexpr (ALIGN_EPI) { if (wr == 0) PG8_BAR; }
        if constexpr (!Epi::AFTER_DRAIN) { E(acc, cur, wr, wc, fr, fq); S.done(cur); }
        if (!has_next) break;
#pragma unroll
        for (int a = 0; a < 2; ++a)
#pragma unroll
            for (int b = 0; b < 2; ++b)
#pragma unroll
                for (int m = 0; m < 4; ++m)
#pragma unroll
                    for (int n = 0; n < 2; ++n) acc[a][b][m][n] = (f32x4){0.f, 0.f, 0.f, 0.f};
        cur = nxt; cA = nA; cB = nB; ++ui;
        if constexpr (ALIGN_EPI) { if (wr == 1) PG8_BAR; }
    }
    PG8_WAIT_V(0);
    if constexpr (!ALIGN_EPI) { if (wr == 0) PG8_BAR; }
    PG8_BAR;
    if constexpr (Epi::AFTER_DRAIN) { E.fused(acc, cur, wr, wc, fr, fq, lds, wid, lane); S.done(cur); }
#undef PG8_SA
#undef PG8_SB
#undef PG8_STAGE
#undef PG8_LDA
#undef PG8_LDB
#undef PG8_MMA
#undef PG8_WAIT_V
#undef PG8_WAIT_L
#undef PG8_BAR
#undef PG8_SCHED
}
}

#include <hip/hip_bf16.h>
#include <cmath>
namespace attn_body {
using bf16=__hip_bfloat16;
using bf16x8=__attribute__((ext_vector_type(8)))short;
using s16x4=__attribute__((ext_vector_type(4)))short;
using f32x16=__attribute__((ext_vector_type(16)))float;
using u32x4=__attribute__((ext_vector_type(4)))unsigned;
constexpr int BATCH=4,NHEAD=16,NKV=4,GRP=NHEAD/NKV,SEQ=8192,D=64,DM=NHEAD*D,KVP=NKV*D;
constexpr int NW=8,QBLK=32,QB=QBLK*NW,KVBLK=64,NQB=SEQ/QB;
constexpr int ATTN_PITCH=DM, ATTN_UNIT_ROWS=QB;
__device__ __forceinline__ int crow(int r,int hi){return (r&3)+8*(r>>2)+4*hi;}
#define SBAR() __builtin_amdgcn_sched_barrier(0)
constexpr int NSLOT=3, SLOTB=8192;
constexpr int LDS_K=0, LDS_V=NSLOT*SLOTB, LDS_WS=2*NSLOT*SLOTB, LDS_OST=LDS_WS+NW*64*4, LDS_BYTES=LDS_OST+NW*4096;
constexpr float C2=0.125f*1.4426950408889634f;
__device__ __forceinline__ void glds16(const void*gsrc,unsigned lds_dst){unsigned keep;
  asm volatile("s_mov_b32 %0, m0\n\ts_mov_b32 m0, %2\n\ts_nop 0\n\tglobal_load_lds_dwordx4 %1, off\n\ts_mov_b32 m0, %0":"=&s"(keep):"v"(gsrc),"s"(lds_dst):"memory");}
__device__ __forceinline__ float max3f(float a,float b,float c){float r;asm("v_max3_f32 %0, %1, %2, %3":"=v"(r):"v"(a),"v"(b),"v"(c));return r;}
__device__ __forceinline__ float max2f(float a,float b){float r;asm("v_max_f32_e32 %0, %1, %2":"=v"(r):"v"(a),"v"(b));return r;}
__device__ __forceinline__ float fadd_s(float a,float b){float r;asm("v_add_f32_e32 %0, %1, %2":"=v"(r):"v"(a),"v"(b));return r;}
__device__ __forceinline__ float fsub_s(float a,float b){float r;asm("v_sub_f32_e32 %0, %1, %2":"=v"(r):"v"(a),"v"(b));return r;}
typedef float f32x2_t __attribute__((ext_vector_type(2))); typedef __bf16 bf16x2_t __attribute__((ext_vector_type(2)));
__device__ __forceinline__ unsigned cvtpk_s(float lo,float hi){f32x2_t v={lo,hi};bf16x2_t b=__builtin_convertvector(v,bf16x2_t);return __builtin_bit_cast(unsigned,b);}
#define WAIT_BAR(N) asm volatile("s_waitcnt vmcnt(" #N ") lgkmcnt(0)\n\ts_barrier":::"memory")

__device__ __forceinline__ void qkt(f32x16&p0,f32x16&p1,const char*Kslot,const bf16x8*qr,const f32x16&negm,int r32,int hi){
  const char*kb=Kslot+hi*1024+r32*16;
  #pragma unroll
  for(int d0=0;d0<4;++d0){
    const bf16x8 b0=*reinterpret_cast<const bf16x8*>(kb+d0*2048);
    const bf16x8 b1=*reinterpret_cast<const bf16x8*>(kb+d0*2048+512);
    if(d0==0){p0=__builtin_amdgcn_mfma_f32_32x32x16_bf16(b0,qr[0],negm,0,0,0);p1=__builtin_amdgcn_mfma_f32_32x32x16_bf16(b1,qr[0],negm,0,0,0);}
    else{p0=__builtin_amdgcn_mfma_f32_32x32x16_bf16(b0,qr[d0],p0,0,0,0);p1=__builtin_amdgcn_mfma_f32_32x32x16_bf16(b1,qr[d0],p1,0,0,0);}}
}
typedef __attribute__((address_space(3))) const char* lds_cptr;
typedef short v4i16_t __attribute__((ext_vector_type(4)));
__device__ __forceinline__ void kload8(bf16x8*kf,lds_cptr kp){
  kf[0]=*(const __attribute__((address_space(3))) bf16x8*)(kp);      kf[1]=*(const __attribute__((address_space(3))) bf16x8*)(kp+512);
  kf[2]=*(const __attribute__((address_space(3))) bf16x8*)(kp+2048); kf[3]=*(const __attribute__((address_space(3))) bf16x8*)(kp+2560);
  kf[4]=*(const __attribute__((address_space(3))) bf16x8*)(kp+4096); kf[5]=*(const __attribute__((address_space(3))) bf16x8*)(kp+4608);
  kf[6]=*(const __attribute__((address_space(3))) bf16x8*)(kp+6144); kf[7]=*(const __attribute__((address_space(3))) bf16x8*)(kp+6656);
}
__device__ __forceinline__ void kload2(bf16x8*kf,lds_cptr kp,int j){ kf[2*j]=*(const __attribute__((address_space(3))) bf16x8*)(kp+j*2048); kf[2*j+1]=*(const __attribute__((address_space(3))) bf16x8*)(kp+j*2048+512); }
__device__ __forceinline__ s16x4 vtr(lds_cptr p){ return __builtin_bit_cast(s16x4,__builtin_amdgcn_ds_read_tr16_b64_v4i16((__attribute__((address_space(3))) v4i16_t*)p)); }
__device__ __forceinline__ float rowmax(const f32x16&p0,const f32x16&p1){
  float a=max3f(p0[0],p0[1],p1[0]),b=max3f(p0[2],p0[3],p1[1]);a=max3f(a,p1[2],p1[3]);
  #pragma unroll
  for(int r=4;r<16;r+=4){a=max3f(a,p0[r],p0[r+1]);b=max3f(b,p0[r+2],p0[r+3]);a=max3f(a,p1[r],p1[r+1]);b=max3f(b,p1[r+2],p1[r+3]);}
  const float m=max2f(a,b);
  auto rr=__builtin_amdgcn_permlane32_swap(__float_as_uint(m),__float_as_uint(m),false,false);
  return max2f(__uint_as_float(rr[0]),__uint_as_float(rr[1]));
}
__device__ __forceinline__ void pv(f32x16*o,int vb,bf16x8 pa0,bf16x8 pa1,bf16x8 pa2,bf16x8 pa3){
  #pragma unroll
  for(int d0=0;d0<2;++d0){s16x4 lo[4],hi[4];
    #pragma unroll
    for(int ks=0;ks<4;++ks){
      asm volatile("ds_read_b64_tr_b16 %0,%1 offset:%c2":"=&v"(lo[ks]):"v"(vb),"i"(d0*4096+ks*1024):"memory");
      asm volatile("ds_read_b64_tr_b16 %0,%1 offset:%c2":"=&v"(hi[ks]):"v"(vb),"i"(d0*4096+ks*1024+512):"memory");}
    asm volatile("s_waitcnt lgkmcnt(0)":::"memory");SBAR();
    #define PK(k) (bf16x8){lo[k][0],lo[k][1],lo[k][2],lo[k][3],hi[k][0],hi[k][1],hi[k][2],hi[k][3]}
    o[d0]=__builtin_amdgcn_mfma_f32_32x32x16_bf16(pa0,PK(0),o[d0],0,0,0);
    o[d0]=__builtin_amdgcn_mfma_f32_32x32x16_bf16(pa1,PK(1),o[d0],0,0,0);
    o[d0]=__builtin_amdgcn_mfma_f32_32x32x16_bf16(pa2,PK(2),o[d0],0,0,0);
    o[d0]=__builtin_amdgcn_mfma_f32_32x32x16_bf16(pa3,PK(3),o[d0],0,0,0);
    #undef PK
  }
}

#ifndef ATTN_STORE16
#define ATTN_STORE16(p,v) (*(u32x4*)(p)=(v))
#endif
template<int THRL,bool NOMAX> __device__ __forceinline__ void attn_unit(int b,int h,int qb,const bf16*Q,const bf16*__restrict__ K,const bf16*__restrict__ V,bf16*O,char*shm,const float*qgain){
  const int tid=otid(),lane=tid&63,r32=lane&31,hi=lane>>5; const int wid=__builtin_amdgcn_readfirstlane(tid>>6);
  const long rowbase=(long)b*SEQ; const int q0=qb*QB;
  const bf16*Qw=Q+(rowbase+q0+wid*QBLK)*DM+h*D;
  const bf16*Kh=K+(long)(b*NKV+h/GRP)*((long)SEQ*D),*Vh=V+(long)(b*NKV+h/GRP)*((long)SEQ*D);
  const unsigned lds0=(unsigned)(uintptr_t)shm;
  float*wsf=(float*)(shm+LDS_WS)+wid*64;
  const bf16*ksrc=Kh+wid*512+lane*8;
  const bf16*vsrc=Vh+wid*512+lane*8;
  const unsigned kdst=lds0+LDS_K+wid*1024, vdst=lds0+LDS_V+wid*1024;
  #define DMA_K(t,slot) glds16(ksrc+(long)(t)*(KVBLK*D),(unsigned)__builtin_amdgcn_readfirstlane(kdst+(slot)))
  #define DMA_V(t,slot) glds16(vsrc+(long)(t)*(KVBLK*D),(unsigned)__builtin_amdgcn_readfirstlane(vdst+(slot)))
  const int vb0=(int)(lds0+LDS_V)+((lane>>4)&1)*32+(lane&3)*8+(4*hi+((lane&15)>>2))*64;
  const char*Kbase=shm+LDS_K; bf16x8 kf[8];
  const lds_cptr shm3=(lds_cptr)shm; const lds_cptr kp0=shm3+LDS_K+hi*1024+r32*16; const lds_cptr vp0=shm3+LDS_V+((lane>>4)&1)*32+(lane&3)*8+(4*hi+((lane&15)>>2))*64;
  const int NT=SEQ/KVBLK;
  DMA_K(0,0);DMA_V(0,0);DMA_K(1,SLOTB);
  bf16x8 qr[4];
  #pragma unroll
  for(int d0=0;d0<4;++d0)qr[d0]=*reinterpret_cast<const bf16x8*>(&Qw[(long)r32*DM+d0*16+hi*8]);
  {
    float xq[4][8]; float ss=0.f;
    #pragma unroll
    for(int d0=0;d0<4;++d0){
      #pragma unroll
      for(int e=0;e<8;++e){ xq[d0][e]=__uint_as_float(((unsigned)(unsigned short)qr[d0][e])<<16); ss+=xq[d0][e]*xq[d0][e]; } }
    ss+=__shfl_xor(ss,32);
    const float rs=__builtin_amdgcn_rsqf(ss*(1.0f/64.0f)+1e-6f);
    const int sq=q0+wid*QBLK+r32; const float prow=(float)(sq>>6), pcol=(float)(sq&63);
    #pragma unroll
    for(int e=0;e<8;++e){ const int ii=8*hi+e; const float inv=exp2f(-(float)ii*0.83048202372184f);
      const float ar=prow*inv, ac=pcol*inv, cr=__cosf(ar), sr=__sinf(ar), cc=__cosf(ac), sc=__sinf(ac);
      const float a=xq[0][e]*rs*qgain[ii], bq=xq[1][e]*rs*qgain[16+ii], a2=xq[2][e]*rs*qgain[32+ii], b2=xq[3][e]*rs*qgain[48+ii];
      const float o0=(a*cr-bq*sr)*C2, o1=(bq*cr+a*sr)*C2, o2=(a2*cc-b2*sc)*C2, o3=(b2*cc+a2*sc)*C2;
      const bf16 h0=__float2bfloat16(o0), h1=__float2bfloat16(o1), h2=__float2bfloat16(o2), h3=__float2bfloat16(o3);
      qr[0][e]=(short)__builtin_bit_cast(unsigned short,h0); qr[1][e]=(short)__builtin_bit_cast(unsigned short,h1); qr[2][e]=(short)__builtin_bit_cast(unsigned short,h2); qr[3][e]=(short)__builtin_bit_cast(unsigned short,h3); }
  }
  float mhat=0.f,l_reg=0.f;f32x16 o[2];o[0]=f32x16{};o[1]=f32x16{};f32x16 negm=f32x16{};asm volatile("":"+v"(negm));
    #define CMASK(P0,P1,t) do{}while(0)
  bool resc=false;
  #define START(P0,P1) do{ resc=false; if constexpr(!NOMAX){ const float rm=rowmax(P0,P1); \
    { const float dl=rm; mhat=fadd_s(mhat,dl); \
      _Pragma("unroll") for(int r=0;r<16;++r){P0[r]=fsub_s(P0[r],dl);P1[r]=fsub_s(P1[r],dl);} \
      _Pragma("unroll") for(int r=0;r<16;++r)negm[r]=-mhat; asm volatile("":"+v"(negm)); } } \
    _Pragma("unroll") for(int r=0;r<16;++r)P0[r]=__builtin_amdgcn_exp2f(P0[r]); }while(0)
  #define RESC() do{ if(resc){ asm volatile("s_waitcnt lgkmcnt(0)":::"memory"); \
      _Pragma("unroll") for(int d_=0;d_<2;++d_) _Pragma("unroll") for(int r=0;r<16;++r)o[d_][r]*=wsf[crow(r,hi)]; } }while(0)
  f32x16 pA0,pA1,pB0,pB1;
  int sl_prev=0,sl_cur=0,sl_next=SLOTB;
  #define ROT() do{sl_prev=sl_cur;sl_cur=sl_next;sl_next=(sl_next==(NSLOT-1)*SLOTB)?0:sl_next+SLOTB;}while(0)
  DMA_K(2,2*SLOTB);
  WAIT_BAR(3);
  qkt(pA0,pA1,Kbase,qr,negm,r32,hi);asm volatile("s_nop 15\n\ts_nop 7":"+v"(pA0),"+v"(pA1));CMASK(pA0,pA1,0);
  START(pA0,pA1);
  _Pragma("unroll") for(int r=0;r<16;++r)pA1[r]=__builtin_amdgcn_exp2f(pA1[r]);
  WAIT_BAR(0);
  DMA_K(3,0);DMA_V(1,SLOTB);
  ROT();
  kload8(kf,kp0+sl_cur);
  WAIT_BAR(2);
  s16x4 vlo[8],vhi[8]; u32x4 pw0,pw1,pw2,pw3;
  #define PKW(P,B) cvtpk_s(P[B],P[B+1])
  #define PAF(k) __builtin_bit_cast(bf16x8,pw##k)
  #define VFR(i) (bf16x8){vlo[i][0],vlo[i][1],vlo[i][2],vlo[i][3],vhi[i][0],vhi[i][1],vhi[i][2],vhi[i][3]}
  #define PIN(x) asm volatile("":"+v"(x))
  #define MX3(a,b,c) __builtin_fmaxf(__builtin_fmaxf((a),(b)),(c))
  #define GAPA(MF,A0,A1,A2,A3,W0,W1,PW) do{ MF; sacc+=A0; sacc+=A1; sacc+=A2; sacc+=A3; PIN(sacc); W0; W1; PIN(PW); SBAR(); }while(0)
  #define EX(v) __builtin_amdgcn_exp2f(v)
  #define GAPB(MF,X,B) do{ MF; X[B]=EX(X[B]); X[B+1]=EX(X[B+1]); X[B+2]=EX(X[B+2]); X[B+3]=EX(X[B+3]); PIN(X); SBAR(); }while(0)
  #define VRD(i) do{ vlo[i]=vtr(vp_+(((i)>>2)*4096+((i)&3)*1024)); vhi[i]=vtr(vp_+(((i)>>2)*4096+((i)&3)*1024+512)); }while(0)
  #define KRD(G,j) do{ if(G){ kload2(kf,kp0+sl_next,j); SBAR(); } }while(0)
  #define STEP(C0,C1,P0,P1,t,GK,GV,GL) do{ SBAR(); \
    const lds_cptr vp_=vp0+sl_prev; \
    VRD(0); SBAR(); float sacc=(P0[0]+P0[1]); \
    GAPA(C0=__builtin_amdgcn_mfma_f32_32x32x16_bf16(kf[0],qr[0],negm,0,0,0), P0[2],P0[3],P0[4],P0[5],     pw0[0]=PKW(P0,0), pw0[1]=PKW(P0,2), pw0); \
    VRD(4); SBAR(); GAPA(C1=__builtin_amdgcn_mfma_f32_32x32x16_bf16(kf[1],qr[0],negm,0,0,0), P0[6],P0[7],P0[8],P0[9],     pw0[2]=PKW(P0,4), pw0[3]=PKW(P0,6), pw0); \
    VRD(1); SBAR(); GAPA(C0=__builtin_amdgcn_mfma_f32_32x32x16_bf16(kf[2],qr[1],C0,0,0,0),   P0[10],P0[11],P0[12],P0[13], pw1[0]=PKW(P0,8), pw1[1]=PKW(P0,10), pw1); \
    VRD(5); SBAR(); GAPA(C1=__builtin_amdgcn_mfma_f32_32x32x16_bf16(kf[3],qr[1],C1,0,0,0),   P0[14],P0[15],P1[0],P1[1],   pw1[2]=PKW(P0,12),pw1[3]=PKW(P0,14), pw1); \
    VRD(2); SBAR(); GAPA(C0=__builtin_amdgcn_mfma_f32_32x32x16_bf16(kf[4],qr[2],C0,0,0,0),   P1[2],P1[3],P1[4],P1[5],     pw2[0]=PKW(P1,0), pw2[1]=PKW(P1,2), pw2); \
    VRD(6); SBAR(); GAPA(C1=__builtin_amdgcn_mfma_f32_32x32x16_bf16(kf[5],qr[2],C1,0,0,0),   P1[6],P1[7],P1[8],P1[9],     pw2[2]=PKW(P1,4), pw2[3]=PKW(P1,6), pw2); \
    VRD(3); SBAR(); GAPA(C0=__builtin_amdgcn_mfma_f32_32x32x16_bf16(kf[6],qr[3],C0,0,0,0),   P1[10],P1[11],P1[12],P1[13], pw3[0]=PKW(P1,8), pw3[1]=PKW(P1,10), pw3); \
    VRD(7); SBAR(); GAPA(C1=__builtin_amdgcn_mfma_f32_32x32x16_bf16(kf[7],qr[3],C1,0,0,0),   P1[14],P1[15],0.f,0.f,       pw3[2]=PKW(P1,12),pw3[3]=PKW(P1,14), pw3); \
    l_reg+=sacc; \
    if(GK){DMA_K((t)+3,sl_cur);} if(GV){DMA_V((t)+1,sl_next);} \
    CMASK(C0,C1,t); \
    resc=false; if constexpr(!NOMAX){ float a=MX3(C0[0],C0[1],C1[0]),b=MX3(C0[2],C0[3],C1[1]); a=MX3(a,C1[2],C1[3]); \
      _Pragma("unroll") for(int r=4;r<16;r+=4){a=MX3(a,C0[r],C0[r+1]);b=MX3(b,C0[r+2],C0[r+3]);a=MX3(a,C1[r],C1[r+1]);b=MX3(b,C1[r+2],C1[r+3]);} \
      float rm=__builtin_fmaxf(a,b); { auto rr=__builtin_amdgcn_permlane32_swap(__float_as_uint(rm),__float_as_uint(rm),false,false); rm=__builtin_fmaxf(__uint_as_float(rr[0]),__uint_as_float(rr[1])); } \
      resc=false; \
      if(__builtin_expect(__any(rm>(float)THRL),0)){ const float dl=__builtin_fmaxf(rm,0.f); mhat+=dl; \
        _Pragma("unroll") for(int r=0;r<16;++r){C0[r]-=dl;C1[r]-=dl;} \
        _Pragma("unroll") for(int r=0;r<16;++r)negm[r]=-mhat; asm volatile("":"+v"(negm)); \
        const float f=__builtin_amdgcn_exp2f(-dl); l_reg*=f; if(hi==0)wsf[r32]=f; resc=true; } } \
    SBAR(); \
    GAPB(o[0]=__builtin_amdgcn_mfma_f32_32x32x16_bf16(PAF(0),VFR(0),o[0],0,0,0), C0,0); \
    GAPB(o[1]=__builtin_amdgcn_mfma_f32_32x32x16_bf16(PAF(0),VFR(4),o[1],0,0,0), C0,4); \
    KRD(GL,0); GAPB(o[0]=__builtin_amdgcn_mfma_f32_32x32x16_bf16(PAF(1),VFR(1),o[0],0,0,0), C0,8); \
    KRD(GL,1); GAPB(o[1]=__builtin_amdgcn_mfma_f32_32x32x16_bf16(PAF(1),VFR(5),o[1],0,0,0), C0,12); \
    KRD(GL,2); GAPB(o[0]=__builtin_amdgcn_mfma_f32_32x32x16_bf16(PAF(2),VFR(2),o[0],0,0,0), C1,0); \
    KRD(GL,3); GAPB(o[1]=__builtin_amdgcn_mfma_f32_32x32x16_bf16(PAF(2),VFR(6),o[1],0,0,0), C1,4); \
    GAPB(o[0]=__builtin_amdgcn_mfma_f32_32x32x16_bf16(PAF(3),VFR(3),o[0],0,0,0), C1,8); \
    GAPB(o[1]=__builtin_amdgcn_mfma_f32_32x32x16_bf16(PAF(3),VFR(7),o[1],0,0,0), C1,12); \
    }while(0)
  int t=1;
  #undef CMASK
  #define CMASK(P0,P1,t) do{}while(0)
  for(;t+5<NT;t+=2){
    STEP(pB0,pB1,pA0,pA1,t,true,true,true);     WAIT_BAR(2); RESC(); ROT();
    STEP(pA0,pA1,pB0,pB1,t+1,true,true,true);   WAIT_BAR(2); RESC(); ROT();
  }
  #undef CMASK
  #define CMASK(P0,P1,t) do{}while(0)
  #define ENDW(tt) do{ if((tt)+3<NT){WAIT_BAR(2);} else if((tt)+2<NT){WAIT_BAR(1);} else {WAIT_BAR(0);} }while(0)
  for(;t+1<NT;t+=2){
    STEP(pB0,pB1,pA0,pA1,t,(t+3<NT),(t+1<NT),(t+1<NT));       ENDW(t);   RESC(); ROT();
    STEP(pA0,pA1,pB0,pB1,t+1,(t+4<NT),(t+2<NT),(t+2<NT));     ENDW(t+1); RESC(); ROT();
  }
  STEP(pB0,pB1,pA0,pA1,NT-1,false,false,false); RESC();
  { float sacc=pB0[0]+pB0[1]; _Pragma("unroll") for(int r=2;r<16;++r)sacc+=pB0[r]; _Pragma("unroll") for(int r=0;r<16;++r)sacc+=pB1[r]; l_reg+=sacc;
    pw0=(u32x4){PKW(pB0,0),PKW(pB0,2),PKW(pB0,4),PKW(pB0,6)};pw1=(u32x4){PKW(pB0,8),PKW(pB0,10),PKW(pB0,12),PKW(pB0,14)};pw2=(u32x4){PKW(pB1,0),PKW(pB1,2),PKW(pB1,4),PKW(pB1,6)};pw3=(u32x4){PKW(pB1,8),PKW(pB1,10),PKW(pB1,12),PKW(pB1,14)};
    SBAR(); pv(o,vb0+sl_cur,PAF(0),PAF(1),PAF(2),PAF(3)); }
  #undef PKW
  #undef PAF
  #undef VFR
  #undef PIN
  #undef MX3
  #undef GAPA
  #undef GAPB
  #undef EX
  #undef VRD
  #undef KRD
  #undef STEP
  #undef ENDW
  {auto rr=__builtin_amdgcn_permlane32_swap(__float_as_uint(l_reg),__float_as_uint(l_reg),false,false);l_reg=__uint_as_float(rr[0])+__uint_as_float(rr[1]);}
  if(hi==0)wsf[32+r32]=l_reg;asm volatile("s_waitcnt lgkmcnt(0)":::"memory");
  float rli[16];
  #pragma unroll
  for(int r=0;r<16;++r)rli[r]=__builtin_amdgcn_rcpf(wsf[32+crow(r,hi)]);
  bf16*Ow=O+(rowbase+q0+wid*QBLK)*DM+h*D;
  { bf16*stg=(bf16*)(shm+LDS_OST)+wid*2048;
    #pragma unroll
    for(int r=0;r<16;++r){const int orow=crow(r,hi);
      #pragma unroll
      for(int d0=0;d0<2;++d0)stg[orow*64+d0*32+r32]=__float2bfloat16(o[d0][r]*rli[r]);}
    asm volatile("s_waitcnt lgkmcnt(0)":::"memory");
    #pragma unroll
    for(int i=0;i<4;++i){const int row=i*8+(lane>>3),ch=lane&7; const u32x4 v=*(const u32x4*)(stg+row*64+ch*8); ATTN_STORE16(Ow+(long)row*DM+ch*8,v);} }
  asm volatile("s_waitcnt lgkmcnt(0)\n\ts_barrier":::"memory");
  #undef DMA_K
  #undef DMA_V
  #undef CMASK
  #undef START
  #undef RESC
  #undef ROT
}
constexpr int ATTN_LDS_BYTES=LDS_BYTES;
struct AttnTensors { const bf16* Q; const bf16* K; const bf16* V; bf16* O; };
struct AttnUnit { int bh; int qb; };
#undef SBAR
#undef WAIT_BAR
}

#include <hip/hip_cooperative_groups.h>
namespace cg = cooperative_groups;
#define LAS __attribute__((address_space(3)))
typedef unsigned short bf16;
typedef unsigned v4u __attribute__((ext_vector_type(4)));
typedef float f32x4 __attribute__((ext_vector_type(4)));
typedef short bf16x8 __attribute__((ext_vector_type(8)));
constexpr int NWAVES = 8, NTHREADS = 512;
constexpr int BATCH = 4, SEQ = 8192, DM = 1024, M = BATCH * SEQ, DFF = 2816, NIN = 5632, NLAYER = 2;
constexpr size_t MiB = 1u << 20;
constexpr size_t WS_ROWSS = 496 * MiB, WS_CIN = 0, WS_P = 2 * MiB, WS_E = 4 * MiB;
constexpr size_t WS_W1A = 6 * MiB, WS_W2A = 17 * MiB, WS_WIN = 22 * MiB + MiB / 2;
constexpr size_t WS_G2 = 34 * MiB, G2_STRIDE = 23 * MiB, G2_WAO = 0, G2_WRO = 2 * MiB, G2_WOUT = 4 * MiB, G2_W1B = 6 * MiB, G2_W2B = 17 * MiB;
constexpr size_t WS_XB = 80 * MiB, WS_Q = 144 * MiB, WS_K = 208 * MiB, WS_V = 224 * MiB, WS_XR = 240 * MiB, WS_YR = 304 * MiB, WS_GL = 368 * MiB, WS_BAR = 508 * MiB, WS_BAR_BYTES = 16384, WS_END = 508 * MiB + 65536;
constexpr size_t WS_HID = 144 * MiB;
constexpr int LDS_BYTES = 147456;
constexpr float RMS_EPS = 1e-6f;

__device__ __forceinline__ unsigned f2bf(float f) { unsigned u = __builtin_bit_cast(unsigned, f); return (u + 0x7fffu + ((u >> 16) & 1u)) >> 16; }
__device__ __forceinline__ unsigned pk2(float lo, float hi) { return f2bf(lo) | (f2bf(hi) << 16); }
__device__ __forceinline__ float bf2f(unsigned short v) { return __uint_as_float((unsigned)v << 16); }
__device__ __forceinline__ float wave_sum(float v) {
#pragma unroll
    for (int o = 1; o < 64; o <<= 1) v += __shfl_xor(v, o);
    return v;
}
__device__ __forceinline__ void transpose_item(const float* W, int K, int N, bf16* WT, const float* gain, bool w1perm, LAS float* scr, int item, int lane) {
    const int nblk = N / 32, kb = item / nblk, nb = item % nblk, k0 = 64 * kb, n0d = 32 * nb;
    const int n0s = w1perm ? (((n0d & 255) >> 7) * DFF + 128 * (n0d >> 8) + (n0d & 127)) : n0d;
#pragma unroll 8
    for (int i = 0; i < 32; ++i) { const int kk = 2 * i + (lane >> 5); float v = W[(size_t)(k0 + kk) * N + n0s + (lane & 31)]; if (gain) v *= gain[k0 + kk]; scr[kk * 33 + (lane & 31)] = v; }
    asm volatile("s_waitcnt lgkmcnt(0)" ::: "memory");
    const int c = lane & 7;
#pragma unroll
    for (int j = 0; j < 4; ++j) { const int n = (lane >> 3) + 8 * j; const LAS float* s = scr + (8 * c) * 33 + n;
        v4u o; o.x = pk2(s[0 * 33], s[1 * 33]); o.y = pk2(s[2 * 33], s[3 * 33]); o.z = pk2(s[4 * 33], s[5 * 33]); o.w = pk2(s[6 * 33], s[7 * 33]);
        *(v4u*)(WT + (size_t)(n0d + n) * K + k0 + 8 * c) = o; }
    asm volatile("s_waitcnt lgkmcnt(0)" ::: "memory");
}
__device__ __forceinline__ void convert_matrix(const float* W, int K, int N, bf16* WT, const float* gain, bool w1perm, LAS float* scr, int gw, int ngw, int lane) {
    const int nitems = (K / 64) * (N / 32);
    for (int it = gw; it < nitems; it += ngw) transpose_item(W, K, N, WT, gain, w1perm, scr, it, lane);
}
struct Params { const float* in[22]; float* out; unsigned char* ws; };
enum { I_X = 0, I_F1N, I_F1W1, I_F1W2, I_MIXN, I_WIN, I_BGATE, I_QN, I_KN, I_WAO, I_CONVW, I_CONVB, I_WA, I_BA, I_WX, I_BX, I_LAM, I_WRO, I_WOUT, I_F2N, I_F2W1, I_F2W2 };

__device__ __forceinline__ void convert_group1(const Params& p, int l, LAS float* scr, int gw, int ngw, int lane) {
    convert_matrix(p.in[I_F1W1] + (size_t)l * DM * NIN, DM, NIN, (bf16*)(p.ws + WS_W1A), p.in[I_F1N] + l * DM, true, scr, gw, ngw, lane);
    convert_matrix(p.in[I_F1W2] + (size_t)l * DFF * DM, DFF, DM, (bf16*)(p.ws + WS_W2A), nullptr, false, scr, gw, ngw, lane);
    convert_matrix(p.in[I_WIN] + (size_t)l * DM * NIN, DM, NIN, (bf16*)(p.ws + WS_WIN), p.in[I_MIXN] + l * DM, false, scr, gw, ngw, lane);
}
__device__ __forceinline__ void convert_group2(const Params& p, int l, LAS float* scr, int gw, int ngw, int lane) {
    unsigned char* g2 = p.ws + WS_G2 + (size_t)l * G2_STRIDE;
    convert_matrix(p.in[I_WAO] + (size_t)l * DM * DM, DM, DM, (bf16*)(g2 + G2_WAO), nullptr, false, scr, gw, ngw, lane);
    convert_matrix(p.in[I_WRO] + (size_t)l * DM * DM, DM, DM, (bf16*)(g2 + G2_WRO), nullptr, false, scr, gw, ngw, lane);
    convert_matrix(p.in[I_WOUT] + (size_t)l * DM * DM, DM, DM, (bf16*)(g2 + G2_WOUT), nullptr, false, scr, gw, ngw, lane);
    convert_matrix(p.in[I_F2W1] + (size_t)l * DM * NIN, DM, NIN, (bf16*)(g2 + G2_W1B), p.in[I_F2N] + l * DM, true, scr, gw, ngw, lane);
    convert_matrix(p.in[I_F2W2] + (size_t)l * DFF * DM, DFF, DM, (bf16*)(g2 + G2_W2B), nullptr, false, scr, gw, ngw, lane);
}
__device__ __forceinline__ void x_rows(const float* x, bf16* xb, float* rowss, int gw, int ngw, int lane) {
    for (int m = gw; m < M; m += ngw) {
        const f32x4* xr = (const f32x4*)(x + (size_t)m * DM) + lane; f32x4 v[4]; float s = 0.f;
#pragma unroll
        for (int j = 0; j < 4; ++j) { v[j] = xr[64 * j]; s += (v[j].x * v[j].x + v[j].y * v[j].y) + (v[j].z * v[j].z + v[j].w * v[j].w); }
        s = wave_sum(s);
        unsigned long long* o8 = (unsigned long long*)(xb + (size_t)m * DM) + lane;
#pragma unroll
        for (int j = 0; j < 4; ++j) o8[64 * j] = (unsigned long long)pk2(v[j].x, v[j].y) | ((unsigned long long)pk2(v[j].z, v[j].w) << 32);
        if (lane < 16) rowss[(size_t)m * 16 + lane] = (lane == 0) ? s : 0.f;
    }
}
__device__ __forceinline__ void qk_rope(bf16* q, bf16* k, const float* qn, const float* kn, int gtid, int nthreads) {
    const int total = M * 4 * 4;
    for (int it = gtid; it < total; it += nthreads) {
        const int q4 = it & 3, th = it >> 2, hh = 16 + (th & 3), tok = th >> 2, half = q4 >> 1, sub = q4 & 1;
        bf16* p = (hh < 16) ? q + (size_t)tok * 1024 + hh * 64 : k + (size_t)tok * 256 + (hh - 16) * 64;
        const float* gn = (hh < 16) ? qn : kn; const float osc = (hh < 16) ? attn_body::C2 : 1.0f;
        bf16* p2;
        if (hh < 16) { p += 32 * half + 8 * sub; p2 = p + 16; }
        else { const int kvh = hh - 16, bb = tok >> 13, sq = tok & 8191, tt = sq >> 6, rr = sq & 63;
               bf16* kb = k + ((size_t)(bb * 4 + kvh) * 128 + tt) * 4096 + rr * 8; p = kb + (4 * half + sub) * 512; p2 = kb + (4 * half + sub + 2) * 512; }
        const v4u w1 = *(const v4u*)p, w2 = *(const v4u*)p2;
        float x1[8], x2[8];
        x1[0] = __uint_as_float(w1.x << 16); x1[1] = __uint_as_float(w1.x & 0xffff0000u); x1[2] = __uint_as_float(w1.y << 16); x1[3] = __uint_as_float(w1.y & 0xffff0000u);
        x1[4] = __uint_as_float(w1.z << 16); x1[5] = __uint_as_float(w1.z & 0xffff0000u); x1[6] = __uint_as_float(w1.w << 16); x1[7] = __uint_as_float(w1.w & 0xffff0000u);
        x2[0] = __uint_as_float(w2.x << 16); x2[1] = __uint_as_float(w2.x & 0xffff0000u); x2[2] = __uint_as_float(w2.y << 16); x2[3] = __uint_as_float(w2.y & 0xffff0000u);
        x2[4] = __uint_as_float(w2.z << 16); x2[5] = __uint_as_float(w2.z & 0xffff0000u); x2[6] = __uint_as_float(w2.w << 16); x2[7] = __uint_as_float(w2.w & 0xffff0000u);
        float ss = 0.f;
#pragma unroll
        for (int i = 0; i < 8; ++i) ss += x1[i] * x1[i] + x2[i] * x2[i];
        ss += __shfl_xor(ss, 1); ss += __shfl_xor(ss, 2);
        const float rs = __builtin_amdgcn_rsqf(ss * (1.0f / 64.0f) + RMS_EPS);
        const int s = tok & (SEQ - 1); const float pos = (float)(half ? (s & 63) : (s >> 6));
        float o1[8], o2[8];
#pragma unroll
        for (int i = 0; i < 8; ++i) { const int ii = 8 * sub + i; const float inv = exp2f(-(float)ii * 0.83048202372184f);
            const float ang = pos * inv, c = __cosf(ang), sn = __sinf(ang);
            const float a = x1[i] * rs * gn[32 * half + ii], b = x2[i] * rs * gn[32 * half + 16 + ii];
            o1[i] = (a * c - b * sn) * osc; o2[i] = (b * c + a * sn) * osc; }
        v4u r1, r2; r1.x = pk2(o1[0], o1[1]); r1.y = pk2(o1[2], o1[3]); r1.z = pk2(o1[4], o1[5]); r1.w = pk2(o1[6], o1[7]);
        r2.x = pk2(o2[0], o2[1]); r2.y = pk2(o2[2], o2[3]); r2.z = pk2(o2[4], o2[5]); r2.w = pk2(o2[6], o2[7]);
        *(v4u*)p = r1; *(v4u*)p2 = r2;
    }
}
constexpr int RL = 128, NCH = SEQ / RL, XCF_STRIDE = 68, XCB_STRIDE = 72, NIT = BATCH * NCH * 16;
constexpr int RNN_XCF = 0, RNN_XCB = RL * XCF_STRIDE * 4, RNN_HS = RNN_XCB + RL * XCB_STRIDE * 2;
__device__ __forceinline__ void rnn_carry(const float* Pb, const float* Eb, float* CIN, int gtid, int nthreads) {
    for (int sq = gtid; sq < BATCH * 2 * 1024; sq += nthreads) {
        const int ch = sq & 1023, d = (sq >> 10) & 1, b = sq >> 11; float carry = 0.f;
        for (int k0 = 0; k0 < NCH; k0 += 8) { float pv[8], ev[8];
#pragma unroll
            for (int u = 0; u < 8; ++u) { const int jj = d ? NCH - 1 - (k0 + u) : k0 + u; const size_t ix = ((size_t)(b * NCH + jj) * 2 + d) * 1024 + ch; pv[u] = Pb[ix]; ev[u] = Eb[ix]; }
#pragma unroll
            for (int u = 0; u < 8; ++u) { const int jj = d ? NCH - 1 - (k0 + u) : k0 + u; const size_t ix = ((size_t)(b * NCH + jj) * 2 + d) * 1024 + ch; CIN[ix] = carry; carry = pv[u] * carry + ev[u]; } }
    }
}
#define RNN_LOAD_XR(IT, DST) do { const int n_ = (IT) & 15, j_ = ((IT) >> 4) & (NCH - 1), b_ = (IT) >> 10; const int s0_ = j_ * RL + tr * 16 - 2; \
        const bf16* src_ = xr + (size_t)b_ * SEQ * 1024 + 64 * n_ + c; \
        _Pragma("unroll") for (int k_ = 0; k_ < 19; ++k_) { const int s_ = s0_ + k_; DST[k_] = (s_ >= 0 && s_ < SEQ) ? src_[(size_t)s_ * 1024] : (unsigned short)0; } } while (0)
template <int PASS> __device__ __forceinline__ void rnn_pass(LAS unsigned char* lds, const bf16* xr, bf16* yr, bf16* yout, float* Pb, float* Eb, const float* CIN, const float* conv_w, const float* conv_b,
        const float* wa, const float* ba, const float* wx, const float* bxp, const float* lam, int bxid, int G) {
    const int tid = otid(), lane = tid & 63, wid = __builtin_amdgcn_readfirstlane(tid >> 6), d = wid & 1, cs = wid >> 1, fr = lane & 15, fq = lane >> 4;
    const int c = tid & 63, tr = tid >> 6;
    LAS float* XCF = (LAS float*)(lds + RNN_XCF); LAS unsigned short* XCB = (LAS unsigned short*)(lds + RNN_XCB); LAS float* HS = (LAS float*)(lds + RNN_HS);
    const int o = d ? 3 - fq : fq, tot_lane = fr + (d ? 0 : 48);
    int n_cur = -1; bf16x8 bwa[2], bwx[2]; float bav = 0.f, bxv = 0.f, sp8 = 0.f;
    bwa[0] = bwa[1] = bwx[0] = bwx[1] = (bf16x8){0, 0, 0, 0, 0, 0, 0, 0};
    unsigned short xcur[19], xnxt[19];
    if (bxid < NIT) RNN_LOAD_XR(bxid, xcur);
    for (int it = bxid; it < NIT; it += G) {
        const int n = it & 15, j = (it >> 4) & (NCH - 1), b = it >> 10;
        if (it + G < NIT) RNN_LOAD_XR(it + G, xnxt);
        {
            const int chc = 64 * n + c;
            const float cw0 = conv_w[chc], cw1 = conv_w[1024 + chc], cw2 = conv_w[2048 + chc], cw3 = conv_w[3072 + chc], cb = conv_b[chc];
#pragma unroll
            for (int k = 0; k < 16; ++k) { const float xc = cb + cw0 * bf2f(xcur[k]) + cw1 * bf2f(xcur[k + 1]) + cw2 * bf2f(xcur[k + 2]) + cw3 * bf2f(xcur[k + 3]);
                XCF[(tr * 16 + k) * XCF_STRIDE + c] = xc; XCB[(tr * 16 + k) * XCB_STRIDE + c] = (unsigned short)f2bf(xc); }
        }
        const int ch = 64 * n + 16 * cs + fr;
        if (n != n_cur) { n_cur = n;
            const float* wap = wa + ((size_t)(d * 16 + n) * 64) * 64 + 16 * cs + fr; const float* wxp = wx + ((size_t)(d * 16 + n) * 64) * 64 + 16 * cs + fr;
#pragma unroll
            for (int s = 0; s < 2; ++s)
#pragma unroll
                for (int jj = 0; jj < 8; ++jj) { const int kk = 32 * s + 8 * fq + jj; bwa[s][jj] = (short)f2bf(wap[kk * 64]); bwx[s][jj] = (short)f2bf(wxp[kk * 64]); }
            bav = ba[d * 1024 + ch]; bxv = bxp[d * 1024 + ch]; sp8 = -8.0f * log1pf(__expf(-lam[d * 1024 + ch])); }
        float carry = 0.f, Pacc = 1.f;
        if (PASS == 3) carry = CIN[((size_t)(b * NCH + j) * 2 + d) * 1024 + ch];
        v4u gy[2] = {(v4u){0u, 0u, 0u, 0u}, (v4u){0u, 0u, 0u, 0u}};
        if (PASS == 3) {
#pragma unroll
            for (int qq = 0; qq < 2; ++qq) { const int w = tid + NTHREADS * qq, t = w >> 3, c8 = (w & 7) * 8; gy[qq] = *(const v4u*)(yr + ((size_t)b * SEQ + j * RL + t) * 1024 + 64 * n + c8); } }
        __syncthreads();
        float av[8][4], uv[8][4], At[8], Ut[8], Ae[8], Ue[8];
#pragma unroll
        for (int tq = 0; tq < RL / 16; ++tq) {
            const int t0 = 16 * (d ? (RL / 16 - 1 - tq) : tq);
            const LAS unsigned char* ap = (const LAS unsigned char*)XCB + (t0 + fr) * (XCB_STRIDE * 2) + fq * 16;
            const bf16x8 a0 = *(const LAS bf16x8*)ap, a1 = *(const LAS bf16x8*)(ap + 64);
            f32x4 pa = (f32x4){0.f, 0.f, 0.f, 0.f}, px = (f32x4){0.f, 0.f, 0.f, 0.f};
            pa = __builtin_amdgcn_mfma_f32_16x16x32_bf16(a0, bwa[0], pa, 0, 0, 0); pa = __builtin_amdgcn_mfma_f32_16x16x32_bf16(a1, bwa[1], pa, 0, 0, 0);
            px = __builtin_amdgcn_mfma_f32_16x16x32_bf16(a0, bwx[0], px, 0, 0, 0); px = __builtin_amdgcn_mfma_f32_16x16x32_bf16(a1, bwx[1], px, 0, 0, 0);
#pragma unroll
            for (int i = 0; i < 4; ++i) { const float xc = XCF[(t0 + 4 * fq + i) * XCF_STRIDE + 16 * cs + fr];
                const float r = pg8::fsigmoid(pa[i] + bav), ig = pg8::fsigmoid(px[i] + bxv), la = sp8 * r, a = __expf(la), x2 = 2.0f * la;
                const float mm = (x2 > -0.02f) ? -x2 * (1.0f + x2 * (0.5f + x2 * (0.16666667f + x2 * 0.041666667f))) : 1.0f - a * a;
                av[tq][i] = a; uv[tq][i] = __builtin_amdgcn_sqrtf(mm) * ig * xc; }
            float A = 1.f, U = 0.f;
#pragma unroll
            for (int s = 0; s < 4; ++s) { const int i = d ? 3 - s : s; U = av[tq][i] * U + uv[tq][i]; A *= av[tq][i]; }
            { const float Ap = d ? __shfl_down(A, 16) : __shfl_up(A, 16), Up = d ? __shfl_down(U, 16) : __shfl_up(U, 16); if (o >= 1) { U = A * Up + U; A = A * Ap; } }
            { const float Ap = d ? __shfl_down(A, 32) : __shfl_up(A, 32), Up = d ? __shfl_down(U, 32) : __shfl_up(U, 32); if (o >= 2) { U = A * Up + U; A = A * Ap; } }
            At[tq] = __shfl(A, tot_lane); Ut[tq] = __shfl(U, tot_lane);
            if (PASS == 3) { float e0 = d ? __shfl_down(A, 16) : __shfl_up(A, 16), e1 = d ? __shfl_down(U, 16) : __shfl_up(U, 16); if (o == 0) { e0 = 1.f; e1 = 0.f; } Ae[tq] = e0; Ue[tq] = e1; }
        }
#pragma unroll
        for (int tq = 0; tq < RL / 16; ++tq) {
            const int t0 = 16 * (d ? (RL / 16 - 1 - tq) : tq);
            if (PASS == 3) { float h = Ae[tq] * carry + Ue[tq];
#pragma unroll
                for (int s = 0; s < 4; ++s) { const int i = d ? 3 - s : s; h = av[tq][i] * h + uv[tq][i]; HS[d * (RL * XCF_STRIDE) + (t0 + 4 * fq + i) * XCF_STRIDE + 16 * cs + fr] = h; } }
            carry = At[tq] * carry + Ut[tq]; Pacc *= At[tq];
        }
        if (PASS == 1) { if (fq == 0) { const size_t ix = ((size_t)(b * NCH + j) * 2 + d) * 1024 + ch; Pb[ix] = Pacc; Eb[ix] = carry; } }
        if (PASS == 3) {
            __syncthreads();
#pragma unroll
            for (int qq = 0; qq < 2; ++qq) { const int w = tid + NTHREADS * qq, t = w >> 3, c8 = (w & 7) * 8;
                const LAS float* h0 = HS + t * XCF_STRIDE + c8; const LAS float* h1 = h0 + RL * XCF_STRIDE;
                bf16* yp = yr + ((size_t)b * SEQ + j * RL + t) * 1024 + 64 * n + c8; const v4u g = gy[qq];
                float hv[8];
#pragma unroll
                for (int e = 0; e < 8; ++e) hv[e] = h0[e] + h1[e];
                v4u ov; ov.x = pk2(hv[0] * pg8::bf_lo(g.x), hv[1] * pg8::bf_hi(g.x)); ov.y = pk2(hv[2] * pg8::bf_lo(g.y), hv[3] * pg8::bf_hi(g.y));
                ov.z = pk2(hv[4] * pg8::bf_lo(g.z), hv[5] * pg8::bf_hi(g.z)); ov.w = pk2(hv[6] * pg8::bf_lo(g.w), hv[7] * pg8::bf_hi(g.w));
                *(v4u*)(yout + (yp - yr)) = ov; }
        }
        __syncthreads();
#pragma unroll
        for (int k = 0; k < 19; ++k) xcur[k] = xnxt[k];
    }
}

#define XB_TMO      128
#define XB_XCNT(j)  (256  + 64 * (j))
#define XB_XSUB(j)  (1280 + 64 * (j))
#define XB_XGEN(j)  (2304 + 64 * (j))
#define XB_TOP      3328
#define XB_TOPGEN   3392
#define XCD_BAR_WORDS 3456
#define XB_SPIN_CAP (1u << 18)

__device__ __forceinline__ unsigned xb_ld(unsigned* p)              { return __hip_atomic_load(p, __ATOMIC_RELAXED, __HIP_MEMORY_SCOPE_AGENT); }
__device__ __forceinline__ unsigned xb_add(unsigned* p, unsigned v) { return __hip_atomic_fetch_add(p, v, __ATOMIC_RELAXED, __HIP_MEMORY_SCOPE_AGENT); }
__device__ __forceinline__ unsigned xb_xcc_id() { return (unsigned)__builtin_amdgcn_s_getreg((3 << 11) | 20) & 0xFu; }
#define XB_SPIN(cond, bar) do { unsigned _sp = 0; while (cond) { __builtin_amdgcn_s_sleep(1); \
    if ((++_sp & 255u) == 0u) { if (xb_ld(&(bar)[XB_TMO])) break; if (_sp > XB_SPIN_CAP) { atomicAdd(&(bar)[XB_TMO], 1u); break; } } } } while (0)

struct XcdBarrier {
    unsigned* bar; unsigned x;
    volatile LAS unsigned* st;
};

__device__ __forceinline__ XcdBarrier xcd_barrier_post(unsigned* bar, volatile LAS unsigned* st) {
    XcdBarrier b; b.bar = bar; b.x = xb_xcc_id(); b.st = st;
    if (threadIdx.x == 0) { const unsigned r = xb_add(&bar[XB_XCNT(b.x)], 1u); st[2] = r; st[3] = b.x; }
    return b;
}
__device__ __forceinline__ void xcd_barrier_complete(unsigned* bar, unsigned x, unsigned& nloc, unsigned& nx) {
    const unsigned G = gridDim.x * gridDim.y * gridDim.z;
    unsigned sum, cnt, mine, sp = 0u;
    for (;;) {
        sum = 0u; cnt = 0u; mine = 0u;
#pragma unroll
        for (unsigned j = 0; j < 16; ++j) { const unsigned c = xb_ld(&bar[XB_XCNT(j)]); sum += c; cnt += (c > 0u) ? 1u : 0u; mine = (j == x) ? c : mine; }
        if (sum == G) break;
        __builtin_amdgcn_s_sleep(1);
        if ((++sp & 255u) == 0u) { if (xb_ld(&bar[XB_TMO])) break; if (sp > XB_SPIN_CAP) { atomicAdd(&bar[XB_TMO], 1u); break; } }
    }
    nloc = mine > 0u ? mine : 1u; nx = cnt > 0u ? cnt : 1u;
}

__device__ __forceinline__ void xcd_barrier(const XcdBarrier& b) {
    asm volatile("s_waitcnt vmcnt(0)" ::: "memory");
    __syncthreads();
    if (threadIdx.x == 0) {
        unsigned* bar = b.bar;
        __builtin_amdgcn_s_waitcnt(0);
        unsigned nloc = b.st[0], nx = b.st[1];
        if (nloc == 0u) { xcd_barrier_complete(bar, b.x, nloc, nx); b.st[0] = nloc; b.st[1] = nx; }
        const unsigned old = xb_add(&bar[XB_XSUB(b.x)], 1u);
        const unsigned gen = old / nloc;
        if (old + 1u == (gen + 1u) * nloc) {
            __builtin_amdgcn_fence(__ATOMIC_RELEASE, "agent");
            asm volatile("s_waitcnt vmcnt(0)" ::: "memory");
            const unsigned og = xb_add(&bar[XB_TOP], 1u);
            const unsigned tg = og / nx;
            if (og + 1u == (tg + 1u) * nx) xb_add(&bar[XB_TOPGEN], 1u);
            else XB_SPIN(xb_ld(&bar[XB_TOPGEN]) == tg, bar);
            __builtin_amdgcn_fence(__ATOMIC_ACQUIRE, "agent");
            xb_add(&bar[XB_XGEN(b.x)], 1u);
            asm volatile("s_waitcnt vmcnt(0)" ::: "memory");
        } else {
            XB_SPIN(xb_ld(&bar[XB_XGEN(b.x)]) == gen, bar);
            __builtin_amdgcn_fence(__ATOMIC_ACQUIRE, "agent");
            asm volatile("s_waitcnt vmcnt(0)" ::: "memory");
        }
    }
    __syncthreads();
}

#define CG_SYNC() do { asm volatile("s_waitcnt vmcnt(0) lgkmcnt(0)" ::: "memory"); grid.sync(); __builtin_amdgcn_fence(__ATOMIC_ACQUIRE, "agent"); asm volatile("s_waitcnt vmcnt(0)" ::: "memory"); } while (0)
#define GRID_SYNC() do { asm volatile("s_waitcnt lgkmcnt(0)" ::: "memory"); xcd_barrier(xbar); } while (0)
__global__ void __launch_bounds__(NTHREADS, 2) mega_fwd(Params p) {
    extern __shared__ __attribute__((aligned(16))) unsigned char lds_raw[];
    cg::grid_group grid = cg::this_grid();
    LAS unsigned char* lds = (LAS unsigned char*)lds_raw;
    const int G = gridDim.x, bx = blockIdx.x;
    volatile LAS unsigned* bst = (volatile LAS unsigned*)(lds + 131072 + 64);
    if (threadIdx.x < 2) bst[threadIdx.x] = 0u;
    __syncthreads();
    const XcdBarrier xbar = xcd_barrier_post((unsigned*)(p.ws + WS_BAR), bst);
    unsigned char* ws = p.ws;
    float* rowss = (float*)(ws + WS_ROWSS);
    bf16* XB = (bf16*)(ws + WS_XB); bf16* QB = (bf16*)(ws + WS_Q); bf16* KB = (bf16*)(ws + WS_K); bf16* VB = (bf16*)(ws + WS_V);
    bf16* XR = (bf16*)(ws + WS_XR); bf16* YR = (bf16*)(ws + WS_YR); bf16* GL = (bf16*)(ws + WS_GL); bf16* HID = (bf16*)(ws + WS_HID); bf16* MERGED = XR;
    float* Pb = (float*)(ws + WS_P); float* Eb = (float*)(ws + WS_E); float* CINb = (float*)(ws + WS_CIN);
#define PH_IDS() const int tid = otid(), lane = tid & 63, wave = __builtin_amdgcn_readfirstlane(tid >> 6), gw = bx * NWAVES + wave, ngw = G * NWAVES; LAS float* scr = (LAS float*)(lds + wave * 16384); (void)lane; (void)gw; (void)ngw; (void)scr

    { PH_IDS();
      convert_group1(p, 0, scr, gw, ngw, lane);
      convert_group2(p, 0, scr, gw, ngw, lane);
      convert_group2(p, 1, scr, gw, ngw, lane);
      x_rows(p.in[I_X], XB, rowss, gw, ngw, lane);
      (void)tid; }
    GRID_SYNC();
    if (p.ws == nullptr) CG_SYNC();
    int vbx_ = bx;
    { unsigned ok = (G % 8 == 0) ? 1u : 0u, nz = 0u, slot = 0u; const unsigned myx = bst[3], rank = bst[2]; unsigned* barw = (unsigned*)(p.ws + WS_BAR);
#pragma unroll
      for (unsigned j = 0; j < 16; ++j) { const unsigned c = xb_ld(&barw[XB_XCNT(j)]); if (c) { if (c != (unsigned)G / 8u) ok = 0u; if (j < myx) ++slot; ++nz; } }
      if (nz != 8u) ok = 0u;
      if (ok) vbx_ = (int)(rank * 8u + slot); }
    const int vbx = __builtin_amdgcn_readfirstlane(vbx_);

#pragma unroll 1
    for (int l = 0; l < NLAYER; ++l) {
        unsigned char* g2 = ws + WS_G2 + (size_t)l * G2_STRIDE;
        float* rs_ffn1 = rowss + (size_t)(3 * l + 0) * M * 16; float* rs_mix = rowss + (size_t)(3 * l + 1) * M * 16; float* rs_ffn2 = rowss + (size_t)(3 * l + 2) * M * 16;
        { pg8::Gemm g{XB, (const bf16*)(ws + WS_W1A), M, NIN, DM}; pg8::StaticOrder S; S.init(M, NIN, G, vbx);
          pg8::EpiSwiglu E{HID, rs_ffn1, DFF}; pg8::gemm_phase<pg8::EpiSwiglu, pg8::StaticOrder, true, true>(lds, g, S, E); }
        GRID_SYNC();
        { pg8::Gemm g{HID, (const bf16*)(ws + WS_W2A), M, DM, DFF}; pg8::StaticOrder S; S.init(M, DM, G, vbx);
          pg8::EpiResid E{XB, nullptr, rs_mix, 0.5f}; pg8::gemm_phase<pg8::EpiResid, pg8::StaticOrder, true, true, true>(lds, g, S, E); }
        GRID_SYNC();
        { pg8::Gemm g{XB, (const bf16*)(ws + WS_WIN), M, NIN, DM}; pg8::StaticOrder S; S.init(M, NIN, G, vbx);
          pg8::EpiIn E{QB, KB, VB, XR, YR, GL, rs_mix, p.in[I_BGATE] + l * 2048}; pg8::gemm_phase<pg8::EpiIn, pg8::StaticOrder, true, true>(lds, g, S, E); }
        GRID_SYNC();
        { PH_IDS(); qk_rope(QB, KB, p.in[I_QN] + l * 64, p.in[I_KN] + l * 64, bx * NTHREADS + tid, G * NTHREADS); }
        rnn_pass<1>(lds, XR, YR, YR, Pb, Eb, CINb, p.in[I_CONVW] + l * 4096, p.in[I_CONVB] + l * 1024, p.in[I_WA] + (size_t)l * 131072, p.in[I_BA] + l * 2048,
                    p.in[I_WX] + (size_t)l * 131072, p.in[I_BX] + l * 2048, p.in[I_LAM] + l * 2048, vbx, G);
        if (l + 1 < NLAYER) { PH_IDS(); convert_group1(p, l + 1, scr, gw, ngw, lane); }
        GRID_SYNC();
        { PH_IDS(); rnn_carry(Pb, Eb, CINb, bx * NTHREADS + tid, G * NTHREADS); }
        GRID_SYNC();
        {
            const int nun = BATCH * 16 * 32;
            bool nomax;
            { const int l64 = otid() & 63; float gq = __builtin_fabsf(p.in[I_QN][l * 64 + l64]), gk = __builtin_fabsf(p.in[I_KN][l * 64 + l64]);
#pragma unroll
              for (int o = 1; o < 64; o <<= 1) { gq = __builtin_fmaxf(gq, __shfl_xor(gq, o)); gk = __builtin_fmaxf(gk, __shfl_xor(gk, o)); }
              nomax = __builtin_amdgcn_readfirstlane((11.6f * gq * gk <= 64.0f) ? 1 : 0) != 0; }
            for (int i = 0; i * G + vbx < nun; ++i) {
                int b, h, qb;
                if (G == 256) { const int xcd = vbx & 7, idx = vbx >> 3, pair = xcd * 2 + (i >> 2); b = pair >> 2; h = (pair & 3) * 4 + (i & 3); qb = idx; }
                else { const int uid = i * G + vbx; qb = uid & 31; h = (uid >> 5) & 15; b = uid >> 9; }
                if (nomax) attn_body::attn_unit<8, true>(b, h, qb, (const attn_body::bf16*)QB, (const attn_body::bf16*)KB, (const attn_body::bf16*)VB, (attn_body::bf16*)QB, (char*)lds_raw, p.in[I_QN] + l * 64);
                else attn_body::attn_unit<8, false>(b, h, qb, (const attn_body::bf16*)QB, (const attn_body::bf16*)KB, (const attn_body::bf16*)VB, (attn_body::bf16*)QB, (char*)lds_raw, p.in[I_QN] + l * 64);
            }
            __syncthreads();
        }
        rnn_pass<3>(lds, XR, YR, YR, Pb, Eb, CINb, p.in[I_CONVW] + l * 4096, p.in[I_CONVB] + l * 1024, p.in[I_WA] + (size_t)l * 131072, p.in[I_BA] + l * 2048,
                    p.in[I_WX] + (size_t)l * 131072, p.in[I_BX] + l * 2048, p.in[I_LAM] + l * 2048, vbx, G);
        GRID_SYNC();
        { pg8::Gemm g{QB, (const bf16*)(g2 + G2_WAO), M, DM, DM}; pg8::StaticOrder S; S.init(M, DM, G, vbx);
          pg8::EpiGate<false> E{MERGED, GL, 0}; pg8::gemm_phase<pg8::EpiGate<false>, pg8::StaticOrder, true, true>(lds, g, S, E); }
        { pg8::Gemm g{YR, (const bf16*)(g2 + G2_WRO), M, DM, DM}; pg8::StaticOrder S; S.init(M, DM, G, vbx);
          pg8::EpiGate<true> E{MERGED, GL, 1024}; pg8::gemm_phase<pg8::EpiGate<true>, pg8::StaticOrder, true, true>(lds, g, S, E); }
        GRID_SYNC();
        { pg8::Gemm g{MERGED, (const bf16*)(g2 + G2_WOUT), M, DM, DM}; pg8::StaticOrder S; S.init(M, DM, G, vbx);
          pg8::EpiResid E{XB, nullptr, rs_ffn2, 1.0f}; pg8::gemm_phase<pg8::EpiResid, pg8::StaticOrder, true, true>(lds, g, S, E); }
        GRID_SYNC();
        { pg8::Gemm g{XB, (const bf16*)(g2 + G2_W1B), M, NIN, DM}; pg8::StaticOrder S; S.init(M, NIN, G, vbx);
          pg8::EpiSwiglu E{HID, rs_ffn2, DFF}; pg8::gemm_phase<pg8::EpiSwiglu, pg8::StaticOrder, true, true>(lds, g, S, E); }
        GRID_SYNC();
        { pg8::Gemm g{HID, (const bf16*)(g2 + G2_W2B), M, DM, DFF}; pg8::StaticOrder S; S.init(M, DM, G, vbx);
          const bool lastl = (l + 1 == NLAYER);
          pg8::EpiResid E{XB, lastl ? p.out : nullptr, lastl ? nullptr : rowss + (size_t)(3 * (l + 1)) * M * 16, 0.5f}; pg8::gemm_phase<pg8::EpiResid, pg8::StaticOrder, true, true, true>(lds, g, S, E); }
        if (l + 1 < NLAYER) GRID_SYNC();
    }
}

extern "C" void kernel_launch(void* const* d_in, const int* in_sizes, int n_in, void* d_out, int out_size, void* d_ws, size_t ws_size, hipStream_t stream) {
    static int grid = 0;
    if (grid == 0) {
        if (n_in != 22 || out_size != M * DM || ws_size < WS_END) { fprintf(stderr, "kernel_launch: unexpected shapes (n_in %d out %d ws %zu)\n", n_in, out_size, ws_size); grid = -1; return; }
        int dev = 0, cus = 0, per_cu = 0;
        hipGetDevice(&dev); hipDeviceGetAttribute(&cus, hipDeviceAttributeMultiprocessorCount, dev);
        hipFuncSetAttribute((const void*)mega_fwd, hipFuncAttributeMaxDynamicSharedMemorySize, LDS_BYTES);
        hipOccupancyMaxActiveBlocksPerMultiprocessor(&per_cu, (const void*)mega_fwd, NTHREADS, LDS_BYTES);
        if (per_cu < 1) { fprintf(stderr, "kernel_launch: occupancy query says %d blocks per CU\n", per_cu); per_cu = 1; }
        (void)hipGetLastError();
        grid = cus;
    }
    if (grid < 0) return;
    if (hipMemsetAsync((char*)d_ws + WS_BAR, 0, WS_BAR_BYTES, stream) != hipSuccess) { fprintf(stderr, "kernel_launch: memset of the barrier words failed\n"); return; }
    Params p{};
    for (int i = 0; i < 22; ++i) p.in[i] = (const float*)d_in[i];
    p.out = (float*)d_out; p.ws = (unsigned char*)d_ws;
    void* args[] = {&p};
    hipError_t e = hipLaunchCooperativeKernel((const void*)mega_fwd, dim3(grid), dim3(NTHREADS), args, LDS_BYTES, stream);
    if (e != hipSuccess) fprintf(stderr, "cooperative launch failed: %s (grid %d)\n", hipGetErrorString(e), grid);
}
```

```cpp
#include <hip/hip_runtime.h>
#include <cstdio>
#include <cstdint>

__device__ __forceinline__ int otid() { int t = threadIdx.x; asm volatile("" : "+v"(t)); return t; }
namespace pg8 {
#define PG8_LAS __attribute__((address_space(3)))
typedef unsigned short bf16_t;
typedef short bf16x8 __attribute__((ext_vector_type(8)));
typedef float f32x4 __attribute__((ext_vector_type(4)));
typedef unsigned u32x4 __attribute__((ext_vector_type(4)));
constexpr int BM = 256, BK = 64, HALF = 128, HTB = HALF * BK * 2  , STAGE_BYTES = 8 * HTB, NXCD = 8, WGM = 8;

__host__ __device__ __forceinline__ int lds_byte(int r, int c) { const int st = (r >> 4) * 2 + (c >> 5), rr = r & 15, cc = c & 31, ob = rr * 64 + cc * 2; return st * 1024 + (ob ^ (((ob >> 9) & 1) << 5)); }
__host__ __device__ __forceinline__ void stage_rc(int b, int& R, int& C) { const int st = b / 1024, sb = b % 1024, swz = sb ^ (((sb >> 9) & 1) << 5); R = (st >> 1) * 16 + swz / 64; C = (st & 1) * 32 + (swz % 64) / 2; }
__host__ __device__ __forceinline__ int perm32(int rho) { const int n = rho >> 4, i = rho & 15; return 8 * (i >> 2) + 4 * n + (i & 3); }

struct Unit { int pm, pn; };
struct Gemm { const bf16_t* A; const bf16_t* Bt; int M, N, K; };

struct StaticOrder {
    int nM, nN, nwg, G, c;
    __host__ __device__ void init(int M, int N, int G_, int c_) { nM = M / BM; nN = N / BM; nwg = nM * nN; G = G_; c = c_; }
    __host__ __device__ bool next(int i, Unit& u) const {
        const long L = (long)i * G + c; if (L >= nwg) return false;
        int wgid = (int)L; { const int q = nwg / NXCD, r = nwg % NXCD, xcd = wgid % NXCD, off = wgid / NXCD; wgid = (xcd < r ? xcd * (q + 1) : r * (q + 1) + (xcd - r) * q) + off; }
        const int nig = WGM * nN, gid = wgid / nig, fm = gid * WGM, gsz = (nM - fm) < WGM ? (nM - fm) : WGM;
        u.pm = fm + ((wgid % nig) % gsz); u.pn = (wgid % nig) / gsz; return true;
    }
    __device__ __forceinline__ void a_ready(const Unit&) const {}
    __device__ __forceinline__ void done(const Unit&) const {}
};


__device__ __forceinline__ unsigned cvt_pk_bf16(float lo, float hi) { unsigned r; asm volatile("v_cvt_pk_bf16_f32 %0, %1, %2" : "=v"(r) : "v"(lo), "v"(hi)); return r; }
__device__ __forceinline__ float bf_lo(unsigned w) { return __uint_as_float(w << 16); }
__device__ __forceinline__ float bf_hi(unsigned w) { return __uint_as_float(w & 0xffff0000u); }
__device__ __forceinline__ float fsigmoid(float x) { return __builtin_amdgcn_rcpf(1.f + __expf(-x)); }
__device__ __forceinline__ float gelu_tanh(float x) { const float z2 = 1.5957691216f * (x + 0.044715f * x * x * x); return x * fsigmoid(z2); }
constexpr float RMS_EPS = 1e-6f;
__device__ __forceinline__ float row_rstd(const float* rowss, int row) { const f32x4* p = (const f32x4*)(rowss + (size_t)row * 16); const f32x4 a = p[0], b = p[1], c = p[2], d = p[3];
    const float s = ((a[0] + a[1]) + (a[2] + a[3])) + ((b[0] + b[1]) + (b[2] + b[3])) + ((c[0] + c[1]) + (c[2] + c[3])) + ((d[0] + d[1]) + (d[2] + d[3])); return __builtin_amdgcn_rsqf(s * (1.0f / 1024.0f) + RMS_EPS); }

struct EpiSwiglu {
    static constexpr bool PERM = true, AFTER_DRAIN = false;
    bf16_t* H; const float* rowss; int ldh;
    __device__ __forceinline__ void operator()(const f32x4 (&acc)[2][2][4][2], const Unit& u, int wr, int wc, int fr, int fq) const {
        const int row0 = u.pm * BM + wr * 64 + fr, col0 = u.pn * HALF + wc * 32 + 8 * fq;
#pragma unroll
        for (int ai = 0; ai < 2; ++ai)
#pragma unroll
            for (int m = 0; m < 4; ++m) { const int row = row0 + ai * HALF + m * 16; const float rs = row_rstd(rowss, row);
                float h[8];
#pragma unroll
                for (int n = 0; n < 2; ++n)
#pragma unroll
                    for (int e = 0; e < 4; ++e) { const float g = acc[ai][0][m][n][e] * rs, uu = acc[ai][1][m][n][e] * rs; h[4 * n + e] = g * fsigmoid(g) * uu; }
                u32x4 w; w.x = cvt_pk_bf16(h[0], h[1]); w.y = cvt_pk_bf16(h[2], h[3]); w.z = cvt_pk_bf16(h[4], h[5]); w.w = cvt_pk_bf16(h[6], h[7]);
                *(u32x4*)(H + (((size_t)u.pm * (ldh / 64) + (col0 >> 6)) * 256 + (row & 255)) * 64 + (col0 & 63)) = w; }
    }
};
struct EpiResid {
    static constexpr bool PERM = true, AFTER_DRAIN = false;
    bf16_t* xb; float* out; float* rowss; float scale;
    __device__ __forceinline__ void operator()(const f32x4 (&acc)[2][2][4][2], const Unit& u, int wr, int wc, int fr, int fq) const {
        const int row0 = u.pm * BM + wr * 64 + fr, col0 = u.pn * BM + wc * 32 + 8 * fq;
#pragma unroll
        for (int ai = 0; ai < 2; ++ai) {
            u32x4 bs[4][2];
#pragma unroll
            for (int m = 0; m < 4; ++m) { const size_t off = (size_t)(row0 + ai * HALF + m * 16) * 1024 + col0;
#pragma unroll
                for (int bj = 0; bj < 2; ++bj) bs[m][bj] = *(const u32x4*)(xb + off + bj * HALF); }
#pragma unroll
            for (int m = 0; m < 4; ++m) { const int row = row0 + ai * HALF + m * 16; const size_t off = (size_t)row * 1024 + col0; float s = 0.f;
#pragma unroll
                for (int bj = 0; bj < 2; ++bj) { const u32x4 b4 = bs[m][bj]; const f32x4 a0 = acc[ai][bj][m][0] * scale, a1 = acc[ai][bj][m][1] * scale;
                    float o[8];
                    o[0] = bf_lo(b4.x) + a0[0]; o[1] = bf_hi(b4.x) + a0[1]; o[2] = bf_lo(b4.y) + a0[2]; o[3] = bf_hi(b4.y) + a0[3];
                    o[4] = bf_lo(b4.z) + a1[0]; o[5] = bf_hi(b4.z) + a1[1]; o[6] = bf_lo(b4.w) + a1[2]; o[7] = bf_hi(b4.w) + a1[3];
                    s += ((o[0] * o[0] + o[1] * o[1]) + (o[2] * o[2] + o[3] * o[3])) + ((o[4] * o[4] + o[5] * o[5]) + (o[6] * o[6] + o[7] * o[7]));
                    if (out) { *(f32x4*)(out + off + bj * HALF) = (f32x4){o[0], o[1], o[2], o[3]}; *(f32x4*)(out + off + bj * HALF + 4) = (f32x4){o[4], o[5], o[6], o[7]}; }
                    else { u32x4 w; w.x = cvt_pk_bf16(o[0], o[1]); w.y = cvt_pk_bf16(o[2], o[3]); w.z = cvt_pk_bf16(o[4], o[5]); w.w = cvt_pk_bf16(o[6], o[7]); *(u32x4*)(xb + off + bj * HALF) = w; } }
                if (rowss) { s += __shfl_xor(s, 16); s += __shfl_xor(s, 32); if (fq == 0) rowss[(size_t)row * 16 + u.pn * 4 + wc] = s; } }
        }
    }
};
struct EpiIn {
    static constexpr bool PERM = true, AFTER_DRAIN = false;
    bf16_t *q, *k, *v, *xr, *yr, *gl; const float* rowss; const float* bgate;
    __device__ __forceinline__ void operator()(const f32x4 (&acc)[2][2][4][2], const Unit& u, int wr, int wc, int fr, int fq) const {
        const int pn = u.pn; bf16_t* base; int ldc, colt, mode = 0;
        if (pn < 4) { base = q; ldc = 1024; colt = 256 * pn; }
        else if (pn == 4) { base = k; ldc = 256; colt = 0; mode = 3; }
        else if (pn == 5) { base = v; ldc = 256; colt = 0; mode = 4; }
        else if (pn < 10) { base = xr; ldc = 1024; colt = 256 * (pn - 6); }
        else if (pn < 14) { base = yr; ldc = 1024; colt = 256 * (pn - 10); mode = 1; }
        else { base = gl; ldc = 2048; colt = 256 * (pn - 14); mode = 2; }
        const int row0 = u.pm * BM + wr * 64 + fr, col0 = colt + wc * 32 + 8 * fq;
        f32x4 bv[2][2];
#pragma unroll
        for (int bj = 0; bj < 2; ++bj)
#pragma unroll
            for (int n = 0; n < 2; ++n) bv[bj][n] = (mode == 2) ? *(const f32x4*)(bgate + col0 + bj * HALF + 4 * n) : (f32x4){0.f, 0.f, 0.f, 0.f};
#pragma unroll
        for (int ai = 0; ai < 2; ++ai)
#pragma unroll
            for (int m = 0; m < 4; ++m) { const int row = row0 + ai * HALF + m * 16; const float rs = row_rstd(rowss, row); bf16_t* rowp = base + (size_t)row * ldc + col0;
#pragma unroll
                for (int bj = 0; bj < 2; ++bj) { float h[8];
#pragma unroll
                    for (int n = 0; n < 2; ++n)
#pragma unroll
                        for (int e = 0; e < 4; ++e) h[4 * n + e] = acc[ai][bj][m][n][e] * rs;
                    if (mode == 1) { asm volatile("" ::: "memory");
#pragma unroll
                        for (int e = 0; e < 8; ++e) h[e] = gelu_tanh(h[e]); }
                    else if (mode == 2) { asm volatile("" ::: "memory");
#pragma unroll
                        for (int e = 0; e < 8; ++e) h[e] = fsigmoid(h[e] + bv[bj][e >> 2][e & 3]); }
                    u32x4 w; w.x = cvt_pk_bf16(h[0], h[1]); w.y = cvt_pk_bf16(h[2], h[3]); w.z = cvt_pk_bf16(h[4], h[5]); w.w = cvt_pk_bf16(h[6], h[7]);
                    if (mode >= 3) {
                        const int col = col0 + bj * HALF, kvh = col >> 6, d0 = col & 63, bb = row >> 13, sq = row & 8191, tt = sq >> 6, rr = sq & 63;
                        const size_t tb = ((size_t)(bb * 4 + kvh) * 128 + tt) * 4096;
                        *(u32x4*)(base + tb + (mode == 3 ? (size_t)((d0 >> 3) * 512 + rr * 8) : (size_t)((d0 >> 5) * 2048 + rr * 32 + (d0 & 31)))) = w;
                    } else *(u32x4*)(rowp + bj * HALF) = w; } }
    }
};
template <bool ACCUM> struct EpiGate {
    static constexpr bool PERM = true, AFTER_DRAIN = false;
    bf16_t* O; const bf16_t* gl; int goff;
    __device__ __forceinline__ void operator()(const f32x4 (&acc)[2][2][4][2], const Unit& u, int wr, int wc, int fr, int fq) const {
        const int row0 = u.pm * BM + wr * 64 + fr, col0 = u.pn * BM + wc * 32 + 8 * fq;
#pragma unroll
        for (int ai = 0; ai < 2; ++ai)
#pragma unroll
            for (int m = 0; m < 4; ++m) { const int row = row0 + ai * HALF + m * 16;
#pragma unroll
                for (int bj = 0; bj < 2; ++bj) { const int col = col0 + bj * HALF;
                    const u32x4 g = *(const u32x4*)(gl + (size_t)row * 2048 + goff + col); bf16_t* op = O + (size_t)row * 1024 + col;
                    u32x4 pv = (u32x4){0u, 0u, 0u, 0u}; if (ACCUM) pv = *(const u32x4*)op;
                    const f32x4 a0 = acc[ai][bj][m][0], a1 = acc[ai][bj][m][1];
                    float h[8];
                    h[0] = bf_lo(g.x) * a0[0]; h[1] = bf_hi(g.x) * a0[1]; h[2] = bf_lo(g.y) * a0[2]; h[3] = bf_hi(g.y) * a0[3];
                    h[4] = bf_lo(g.z) * a1[0]; h[5] = bf_hi(g.z) * a1[1]; h[6] = bf_lo(g.w) * a1[2]; h[7] = bf_hi(g.w) * a1[3];
                    if (ACCUM) { h[0] += bf_lo(pv.x); h[1] += bf_hi(pv.x); h[2] += bf_lo(pv.y); h[3] += bf_hi(pv.y); h[4] += bf_lo(pv.z); h[5] += bf_hi(pv.z); h[6] += bf_lo(pv.w); h[7] += bf_hi(pv.w); }
                    u32x4 w; w.x = cvt_pk_bf16(h[0], h[1]); w.y = cvt_pk_bf16(h[2], h[3]); w.z = cvt_pk_bf16(h[4], h[5]); w.w = cvt_pk_bf16(h[6], h[7]);
                    *(u32x4*)op = w; } }
    }
};

template <class Epi, class Sched, bool ALIGN_EPI = false, bool SP2 = false, bool ATILED = false>
__device__ __forceinline__ void gemm_phase(PG8_LAS unsigned char* lds, const Gemm g, const Sched& S, const Epi& E) {
    const int tid = otid(), wid = __builtin_amdgcn_readfirstlane(tid >> 6), lane = tid & 63, wr = wid >> 2, wc = wid & 3, fr = lane & 15, fq = lane >> 4;
    const int K = g.K, nt = K / BK;
    unsigned voffA[2], voffB[2];
#pragma unroll
    for (int i = 0; i < 2; ++i) { int R, C; stage_rc(tid * 16 + i * 8192, R, C); const int Rb = Epi::PERM ? ((R & ~31) + perm32(R & 31)) : R;
        voffA[i] = ATILED ? (unsigned)(R * 64 + C) * 2u : (unsigned)(R * K + C) * 2u; voffB[i] = (unsigned)(Rb * K + C) * 2u; }
    const size_t kstep = (size_t)(BK * 2);
    const size_t hstep = (size_t)HALF * K * 2;
    const size_t tstep = 2 * hstep;
    const size_t kstepA = ATILED ? (size_t)32768 : kstep, hstepA = ATILED ? (size_t)16384 : hstep, tstepA = ATILED ? (size_t)(K / BK) * 32768 : tstep;
    const unsigned ldsw = (unsigned)wid * 1024u;
    const int aoff = lds_byte(wr * 64 + fr, fq * 8), boff = lds_byte(wc * 32 + fr, fq * 8);
#define PG8_SA(b, h) (((b) * 2 + (h)) * HTB)
#define PG8_SB(b, h) ((4 + (b) * 2 + (h)) * HTB)
#define PG8_STAGE(bufoff, gbase, voff) do { _Pragma("unroll") for (int _i = 0; _i < 2; ++_i) \
        __builtin_amdgcn_global_load_lds((const unsigned*)((const char*)(gbase) + (voff)[_i]), (PG8_LAS unsigned*)(lds + (bufoff) + ldsw + _i * 8192), 16, 0, 0); } while (0)
#define PG8_LDA(dst, b, h) do { _Pragma("unroll") for (int m = 0; m < 4; ++m) _Pragma("unroll") for (int k = 0; k < 2; ++k) dst[m][k] = *(const PG8_LAS bf16x8*)(lds + PG8_SA(b, h) + aoff + m * 2048 + k * 1024); } while (0)
#define PG8_LDB(dst, b, h) do { _Pragma("unroll") for (int n = 0; n < 2; ++n) _Pragma("unroll") for (int k = 0; k < 2; ++k) dst[n][k] = *(const PG8_LAS bf16x8*)(lds + PG8_SB(b, h) + boff + n * 2048 + k * 1024); } while (0)
#define PG8_MMA(ai, bj, At, Bt) do { __builtin_amdgcn_s_setprio(1); _Pragma("unroll") for (int m = 0; m < 4; ++m) _Pragma("unroll") for (int n = 0; n < 2; ++n) _Pragma("unroll") for (int k = 0; k < 2; ++k) \
        acc[ai][bj][m][n] = __builtin_amdgcn_mfma_f32_16x16x32_bf16(Bt[n][k], At[m][k], acc[ai][bj][m][n], 0, 0, 0); __builtin_amdgcn_s_setprio(0); } while (0)
#define PG8_WAIT_V(n) asm volatile("s_waitcnt vmcnt(" #n ")" ::: "memory")
#define PG8_WAIT_L(n) asm volatile("s_waitcnt lgkmcnt(" #n ")" ::: "memory")
#define PG8_BAR __builtin_amdgcn_s_barrier()
#define PG8_SCHED __builtin_amdgcn_sched_barrier(0)
    Unit cur, nxt; int ui = 0;
    if (!S.next(0, cur)) return;
    f32x4 acc[2][2][4][2];
#pragma unroll
    for (int a = 0; a < 2; ++a)
#pragma unroll
        for (int b = 0; b < 2; ++b)
#pragma unroll
            for (int m = 0; m < 4; ++m)
#pragma unroll
                for (int n = 0; n < 2; ++n) acc[a][b][m][n] = (f32x4){0.f, 0.f, 0.f, 0.f};
    bf16x8 At[4][2], B0[2][2], B1[2][2];
    const char* cA = (const char*)g.A + (size_t)cur.pm * tstepA; const char* cB = (const char*)g.Bt + (size_t)cur.pn * tstep;
    S.a_ready(cur);
    if constexpr (SP2) {
        PG8_STAGE(PG8_SB(0, 0), cB, voffB); PG8_STAGE(PG8_SB(0, 1), cB + hstep, voffB); PG8_STAGE(PG8_SA(0, 0), cA, voffA); PG8_STAGE(PG8_SA(0, 1), cA + hstepA, voffA);
        if (wr == 1) PG8_BAR;
        PG8_WAIT_V(2); PG8_BAR;
        PG8_STAGE(PG8_SB(1, 0), cB + kstep, voffB); PG8_STAGE(PG8_SA(1, 0), cA + kstepA, voffA); PG8_STAGE(PG8_SB(1, 1), cB + hstep + kstep, voffB);
        PG8_WAIT_V(6); PG8_BAR;
    } else {
        PG8_STAGE(PG8_SB(0, 0), cB, voffB); PG8_STAGE(PG8_SA(0, 0), cA, voffA); PG8_STAGE(PG8_SB(0, 1), cB + hstep, voffB); PG8_STAGE(PG8_SA(0, 1), cA + hstepA, voffA);
        if (wr == 1) PG8_BAR;
        PG8_WAIT_V(4); PG8_BAR;
        PG8_STAGE(PG8_SB(1, 0), cB + kstep, voffB); PG8_STAGE(PG8_SA(1, 0), cA + kstepA, voffA); PG8_STAGE(PG8_SB(1, 1), cB + hstep + kstep, voffB);
        PG8_WAIT_V(6); PG8_BAR;
    }
    for (;;) {
        const bool has_next = S.next(ui + 1, nxt);
        const char* nA = has_next ? (const char*)g.A + (size_t)nxt.pm * tstepA : cA; const char* nB = has_next ? (const char*)g.Bt + (size_t)nxt.pn * tstep : cB;
        for (int t = 0; t < nt; t += 2) {
            const bool last = (t == nt - 2);
            const char* a1 = cA + (size_t)(t + 1) * kstepA;
            const char* a2 = last ? nA : cA + (size_t)(t + 2) * kstepA; const char* b2 = last ? nB : cB + (size_t)(t + 2) * kstep;
            const char* a3 = a2 + kstepA; const char* b3 = b2 + kstep;
            if (last && has_next) S.a_ready(nxt);
            if constexpr (SP2) {
            PG8_LDB(B0, 0, 0); PG8_LDB(B1, 0, 1); PG8_SCHED; PG8_LDA(At, 0, 0); PG8_STAGE(PG8_SA(1, 1), a1 + hstepA, voffA);
            PG8_WAIT_V(8); PG8_WAIT_L(0); PG8_BAR; PG8_MMA(0, 0, At, B0); PG8_MMA(0, 1, At, B1); PG8_BAR; PG8_SCHED;
            PG8_LDA(At, 0, 1); PG8_STAGE(PG8_SB(0, 0), b2, voffB); PG8_STAGE(PG8_SB(0, 1), b2 + hstep, voffB); PG8_STAGE(PG8_SA(0, 0), a2, voffA);
            PG8_WAIT_V(8); PG8_WAIT_L(0); PG8_BAR; PG8_MMA(1, 0, At, B0); PG8_MMA(1, 1, At, B1); PG8_BAR; PG8_SCHED;
            PG8_LDB(B0, 1, 0); PG8_LDB(B1, 1, 1); PG8_SCHED; PG8_LDA(At, 1, 0); PG8_STAGE(PG8_SA(0, 1), a2 + hstepA, voffA);
            PG8_WAIT_V(8); PG8_WAIT_L(0); PG8_BAR; PG8_MMA(0, 0, At, B0); PG8_MMA(0, 1, At, B1); PG8_BAR; PG8_SCHED;
            PG8_LDA(At, 1, 1); PG8_STAGE(PG8_SB(1, 0), b3, voffB); PG8_STAGE(PG8_SB(1, 1), b3 + hstep, voffB); PG8_STAGE(PG8_SA(1, 0), a3, voffA);
            PG8_WAIT_V(8); PG8_WAIT_L(0); PG8_BAR; PG8_MMA(1, 0, At, B0); PG8_MMA(1, 1, At, B1); PG8_BAR; PG8_SCHED;
            } else {
            PG8_LDB(B0, 0, 0); PG8_SCHED; PG8_LDA(At, 0, 0); PG8_STAGE(PG8_SA(1, 1), a1 + hstepA, voffA);
            PG8_WAIT_L(8); PG8_BAR; PG8_WAIT_L(0); PG8_MMA(0, 0, At, B0); PG8_BAR; PG8_SCHED;
            PG8_LDB(B1, 0, 1); PG8_STAGE(PG8_SB(0, 0), b2, voffB);
            PG8_BAR; PG8_WAIT_L(0); PG8_MMA(0, 1, At, B1); PG8_BAR;
            PG8_LDA(At, 0, 1); PG8_STAGE(PG8_SA(0, 0), a2, voffA);
            PG8_BAR; PG8_WAIT_L(0); PG8_MMA(1, 0, At, B0); PG8_BAR; PG8_SCHED;
            PG8_STAGE(PG8_SB(0, 1), b2 + hstep, voffB);
            PG8_WAIT_V(6); PG8_BAR; PG8_MMA(1, 1, At, B1); PG8_BAR;
            PG8_LDB(B0, 1, 0); PG8_SCHED; PG8_LDA(At, 1, 0); PG8_STAGE(PG8_SA(0, 1), a2 + hstepA, voffA);
            PG8_WAIT_L(8); PG8_BAR; PG8_WAIT_L(0); PG8_MMA(0, 0, At, B0); PG8_BAR; PG8_SCHED;
            PG8_LDB(B1, 1, 1); PG8_STAGE(PG8_SB(1, 0), b3, voffB);
            PG8_BAR; PG8_WAIT_L(0); PG8_MMA(0, 1, At, B1); PG8_BAR;
            PG8_LDA(At, 1, 1); PG8_STAGE(PG8_SA(1, 0), a3, voffA);
            PG8_BAR; PG8_WAIT_L(0); PG8_MMA(1, 0, At, B0); PG8_BAR; PG8_SCHED;
            PG8_STAGE(PG8_SB(1, 1), b3 + hstep, voffB);
            PG8_WAIT_V(6); PG8_BAR; PG8_MMA(1, 1, At, B1); PG8_BAR;
            }
        }
        if constexpr (ALIGN_EPI) { if (wr == 0) PG8_BAR; }
        if constexpr (!Epi::AFTER_DRAIN) { E(acc, cur, wr, wc, fr, fq); S.done(cur); }
        if (!has_next) break;
#pragma unroll
        for (int a = 0; a < 2; ++a)
#pragma unroll
            for (int b = 0; b < 2; ++b)
#pragma unroll
                for (int m = 0; m < 4; ++m)
#pragma unroll
                    for (int n = 0; n < 2; ++n) acc[a][b][m][n] = (f32x4){0.f, 0.f, 0.f, 0.f};
        cur = nxt; cA = nA; cB = nB; ++ui;
        if constexpr (ALIGN_EPI) { if (wr == 1) PG8_BAR; }
    }
    PG8_WAIT_V(0);
    if constexpr (!ALIGN_EPI) { if (wr == 0) PG8_BAR; }
    PG8_BAR;
    if constexpr (Epi::AFTER_DRAIN) { E.fused(acc, cur, wr, wc, fr, fq, lds, wid, lane); S.done(cur); }
#undef PG8_SA
#undef PG8_SB
#undef PG8_STAGE
#undef PG8_LDA
#undef PG8_LDB
#undef PG8_MMA
#undef PG8_WAIT_V
#undef PG8_WAIT_L
#undef PG8_BAR
#undef PG8_SCHED
}
}

#include <hip/hip_bf16.h>
#include <cmath>
namespace attn_body {
using bf16=__hip_bfloat16;
using bf16x8=__attribute__((ext_vector_type(8)))short;
using s16x4=__attribute__((ext_vector_type(4)))short;
using f32x16=__attribute__((ext_vector_type(16)))float;
using u32x4=__attribute__((ext_vector_type(4)))unsigned;
constexpr int BATCH=4,NHEAD=16,NKV=4,GRP=NHEAD/NKV,SEQ=8192,D=64,DM=NHEAD*D,KVP=NKV*D;
constexpr int NW=8,QBLK=32,QB=QBLK*NW,KVBLK=64,NQB=SEQ/QB;
constexpr int ATTN_PITCH=DM, ATTN_UNIT_ROWS=QB;
__device__ __forceinline__ int crow(int r,int hi){return (r&3)+8*(r>>2)+4*hi;}
#define SBAR() __builtin_amdgcn_sched_barrier(0)
constexpr int NSLOT=3, SLOTB=8192;
constexpr int LDS_K=0, LDS_V=NSLOT*SLOTB, LDS_WS=2*NSLOT*SLOTB, LDS_OST=LDS_WS+NW*64*4, LDS_BYTES=LDS_OST+NW*4096;
constexpr float C2=0.125f*1.4426950408889634f;
__device__ __forceinline__ void glds16(const void*gsrc,unsigned lds_dst){unsigned keep;
  asm volatile("s_mov_b32 %0, m0\n\ts_mov_b32 m0, %2\n\ts_nop 0\n\tglobal_load_lds_dwordx4 %1, off\n\ts_mov_b32 m0, %0":"=&s"(keep):"v"(gsrc),"s"(lds_dst):"memory");}
__device__ __forceinline__ float max3f(float a,float b,float c){float r;asm("v_max3_f32 %0, %1, %2, %3":"=v"(r):"v"(a),"v"(b),"v"(c));return r;}
__device__ __forceinline__ float max2f(float a,float b){float r;asm("v_max_f32_e32 %0, %1, %2":"=v"(r):"v"(a),"v"(b));return r;}
__device__ __forceinline__ float fadd_s(float a,float b){float r;asm("v_add_f32_e32 %0, %1, %2":"=v"(r):"v"(a),"v"(b));return r;}
__device__ __forceinline__ float fsub_s(float a,float b){float r;asm("v_sub_f32_e32 %0, %1, %2":"=v"(r):"v"(a),"v"(b));return r;}
typedef float f32x2_t __attribute__((ext_vector_type(2))); typedef __bf16 bf16x2_t __attribute__((ext_vector_type(2)));
__device__ __forceinline__ unsigned cvtpk_s(float lo,float hi){f32x2_t v={lo,hi};bf16x2_t b=__builtin_convertvector(v,bf16x2_t);return __builtin_bit_cast(unsigned,b);}
#define WAIT_BAR(N) asm volatile("s_waitcnt vmcnt(" #N ") lgkmcnt(0)\n\ts_barrier":::"memory")

__device__ __forceinline__ void qkt(f32x16&p0,f32x16&p1,const char*Kslot,const bf16x8*qr,const f32x16&negm,int r32,int hi){
  const char*kb=Kslot+hi*1024+r32*16;
  #pragma unroll
  for(int d0=0;d0<4;++d0){
    const bf16x8 b0=*reinterpret_cast<const bf16x8*>(kb+d0*2048);
    const bf16x8 b1=*reinterpret_cast<const bf16x8*>(kb+d0*2048+512);
    if(d0==0){p0=__builtin_amdgcn_mfma_f32_32x32x16_bf16(b0,qr[0],negm,0,0,0);p1=__builtin_amdgcn_mfma_f32_32x32x16_bf16(b1,qr[0],negm,0,0,0);}
    else{p0=__builtin_amdgcn_mfma_f32_32x32x16_bf16(b0,qr[d0],p0,0,0,0);p1=__builtin_amdgcn_mfma_f32_32x32x16_bf16(b1,qr[d0],p1,0,0,0);}}
}
typedef __attribute__((address_space(3))) const char* lds_cptr;
typedef short v4i16_t __attribute__((ext_vector_type(4)));
__device__ __forceinline__ void kload8(bf16x8*kf,lds_cptr kp){
  kf[0]=*(const __attribute__((address_space(3))) bf16x8*)(kp);      kf[1]=*(const __attribute__((address_space(3))) bf16x8*)(kp+512);
  kf[2]=*(const __attribute__((address_space(3))) bf16x8*)(kp+2048); kf[3]=*(const __attribute__((address_space(3))) bf16x8*)(kp+2560);
  kf[4]=*(const __attribute__((address_space(3))) bf16x8*)(kp+4096); kf[5]=*(const __attribute__((address_space(3))) bf16x8*)(kp+4608);
  kf[6]=*(const __attribute__((address_space(3))) bf16x8*)(kp+6144); kf[7]=*(const __attribute__((address_space(3))) bf16x8*)(kp+6656);
}
__device__ __forceinline__ void kload2(bf16x8*kf,lds_cptr kp,int j){ kf[2*j]=*(const __attribute__((address_space(3))) bf16x8*)(kp+j*2048); kf[2*j+1]=*(const __attribute__((address_space(3))) bf16x8*)(kp+j*2048+512); }
__device__ __forceinline__ s16x4 vtr(lds_cptr p){ return __builtin_bit_cast(s16x4,__builtin_amdgcn_ds_read_tr16_b64_v4i16((__attribute__((address_space(3))) v4i16_t*)p)); }
__device__ __forceinline__ float rowmax(const f32x16&p0,const f32x16&p1){
  float a=max3f(p0[0],p0[1],p1[0]),b=max3f(p0[2],p0[3],p1[1]);a=max3f(a,p1[2],p1[3]);
  #pragma unroll
  for(int r=4;r<16;r+=4){a=max3f(a,p0[r],p0[r+1]);b=max3f(b,p0[r+2],p0[r+3]);a=max3f(a,p1[r],p1[r+1]);b=max3f(b,p1[r+2],p1[r+3]);}
  const float m=max2f(a,b);
  auto rr=__builtin_amdgcn_permlane32_swap(__float_as_uint(m),__float_as_uint(m),false,false);
  return max2f(__uint_as_float(rr[0]),__uint_as_float(rr[1]));
}
__device__ __forceinline__ void pv(f32x16*o,int vb,bf16x8 pa0,bf16x8 pa1,bf16x8 pa2,bf16x8 pa3){
  #pragma unroll
  for(int d0=0;d0<2;++d0){s16x4 lo[4],hi[4];
    #pragma unroll
    for(int ks=0;ks<4;++ks){
      asm volatile("ds_read_b64_tr_b16 %0,%1 offset:%c2":"=&v"(lo[ks]):"v"(vb),"i"(d0*4096+ks*1024):"memory");
      asm volatile("ds_read_b64_tr_b16 %0,%1 offset:%c2":"=&v"(hi[ks]):"v"(vb),"i"(d0*4096+ks*1024+512):"memory");}
    asm volatile("s_waitcnt lgkmcnt(0)":::"memory");SBAR();
    #define PK(k) (bf16x8){lo[k][0],lo[k][1],lo[k][2],lo[k][3],hi[k][0],hi[k][1],hi[k][2],hi[k][3]}
    o[d0]=__builtin_amdgcn_mfma_f32_32x32x16_bf16(pa0,PK(0),o[d0],0,0,0);
    o[d0]=__builtin_amdgcn_mfma_f32_32x32x16_bf16(pa1,PK(1),o[d0],0,0,0);
    o[d0]=__builtin_amdgcn_mfma_f32_32x32x16_bf16(pa2,PK(2),o[d0],0,0,0);
    o[d0]=__builtin_amdgcn_mfma_f32_32x32x16_bf16(pa3,PK(3),o[d0],0,0,0);
    #undef PK
  }
}

#ifndef ATTN_STORE16
#define ATTN_STORE16(p,v) (*(u32x4*)(p)=(v))
#endif
template<int THRL,bool NOMAX> __device__ __forceinline__ void attn_unit(int b,int h,int qb,const bf16*Q,const bf16*__restrict__ K,const bf16*__restrict__ V,bf16*O,char*shm,const float*qgain){
  const int tid=otid(),lane=tid&63,r32=lane&31,hi=lane>>5; const int wid=__builtin_amdgcn_readfirstlane(tid>>6);
  const long rowbase=(long)b*SEQ; const int q0=qb*QB;
  const bf16*Qw=Q+(rowbase+q0+wid*QBLK)*DM+h*D;
  const bf16*Kh=K+(long)(b*NKV+h/GRP)*((long)SEQ*D),*Vh=V+(long)(b*NKV+h/GRP)*((long)SEQ*D);
  const unsigned lds0=(unsigned)(uintptr_t)shm;
  float*wsf=(float*)(shm+LDS_WS)+wid*64;
  const bf16*ksrc=Kh+wid*512+lane*8;
  const bf16*vsrc=Vh+wid*512+lane*8;
  const unsigned kdst=lds0+LDS_K+wid*1024, vdst=lds0+LDS_V+wid*1024;
  #define DMA_K(t,slot) glds16(ksrc+(long)(t)*(KVBLK*D),(unsigned)__builtin_amdgcn_readfirstlane(kdst+(slot)))
  #define DMA_V(t,slot) glds16(vsrc+(long)(t)*(KVBLK*D),(unsigned)__builtin_amdgcn_readfirstlane(vdst+(slot)))
  const int vb0=(int)(lds0+LDS_V)+((lane>>4)&1)*32+(lane&3)*8+(4*hi+((lane&15)>>2))*64;
  const char*Kbase=shm+LDS_K; bf16x8 kf[8];
  const lds_cptr shm3=(lds_cptr)shm; const lds_cptr kp0=shm3+LDS_K+hi*1024+r32*16; const lds_cptr vp0=shm3+LDS_V+((lane>>4)&1)*32+(lane&3)*8+(4*hi+((lane&15)>>2))*64;
  const int NT=SEQ/KVBLK;
  DMA_K(0,0);DMA_V(0,0);DMA_K(1,SLOTB);
  bf16x8 qr[4];
  #pragma unroll
  for(int d0=0;d0<4;++d0)qr[d0]=*reinterpret_cast<const bf16x8*>(&Qw[(long)r32*DM+d0*16+hi*8]);
  {
    float xq[4][8]; float ss=0.f;
    #pragma unroll
    for(int d0=0;d0<4;++d0){
      #pragma unroll
      for(int e=0;e<8;++e){ xq[d0][e]=__uint_as_float(((unsigned)(unsigned short)qr[d0][e])<<16); ss+=xq[d0][e]*xq[d0][e]; } }
    ss+=__shfl_xor(ss,32);
    const float rs=__builtin_amdgcn_rsqf(ss*(1.0f/64.0f)+1e-6f);
    const int sq=q0+wid*QBLK+r32; const float prow=(float)(sq>>6), pcol=(float)(sq&63);
    #pragma unroll
    for(int e=0;e<8;++e){ const int ii=8*hi+e; const float inv=exp2f(-(float)ii*0.83048202372184f);
      const float ar=prow*inv, ac=pcol*inv, cr=__cosf(ar), sr=__sinf(ar), cc=__cosf(ac), sc=__sinf(ac);
      const float a=xq[0][e]*rs*qgain[ii], bq=xq[1][e]*rs*qgain[16+ii], a2=xq[2][e]*rs*qgain[32+ii], b2=xq[3][e]*rs*qgain[48+ii];
      const float o0=(a*cr-bq*sr)*C2, o1=(bq*cr+a*sr)*C2, o2=(a2*cc-b2*sc)*C2, o3=(b2*cc+a2*sc)*C2;
      const bf16 h0=__float2bfloat16(o0), h1=__float2bfloat16(o1), h2=__float2bfloat16(o2), h3=__float2bfloat16(o3);
      qr[0][e]=(short)__builtin_bit_cast(unsigned short,h0); qr[1][e]=(short)__builtin_bit_cast(unsigned short,h1); qr[2][e]=(short)__builtin_bit_cast(unsigned short,h2); qr[3][e]=(short)__builtin_bit_cast(unsigned short,h3); }
  }
  float mhat=0.f,l_reg=0.f;f32x16 o[2];o[0]=f32x16{};o[1]=f32x16{};f32x16 negm=f32x16{};asm volatile("":"+v"(negm));
    #define CMASK(P0,P1,t) do{}while(0)
  bool resc=false;
  #define START(P0,P1) do{ resc=false; if constexpr(!NOMAX){ const float rm=rowmax(P0,P1); \
    { const float dl=rm; mhat=fadd_s(mhat,dl); \
      _Pragma("unroll") for(int r=0;r<16;++r){P0[r]=fsub_s(P0[r],dl);P1[r]=fsub_s(P1[r],dl);} \
      _Pragma("unroll") for(int r=0;r<16;++r)negm[r]=-mhat; asm volatile("":"+v"(negm)); } } \
    _Pragma("unroll") for(int r=0;r<16;++r)P0[r]=__builtin_amdgcn_exp2f(P0[r]); }while(0)
  #define RESC() do{ if(resc){ asm volatile("s_waitcnt lgkmcnt(0)":::"memory"); \
      _Pragma("unroll") for(int d_=0;d_<2;++d_) _Pragma("unroll") for(int r=0;r<16;++r)o[d_][r]*=wsf[crow(r,hi)]; } }while(0)
  f32x16 pA0,pA1,pB0,pB1;
  int sl_prev=0,sl_cur=0,sl_next=SLOTB;
  #define ROT() do{sl_prev=sl_cur;sl_cur=sl_next;sl_next=(sl_next==(NSLOT-1)*SLOTB)?0:sl_next+SLOTB;}while(0)
  DMA_K(2,2*SLOTB);
  WAIT_BAR(3);
  qkt(pA0,pA1,Kbase,qr,negm,r32,hi);asm volatile("s_nop 15\n\ts_nop 7":"+v"(pA0),"+v"(pA1));CMASK(pA0,pA1,0);
  START(pA0,pA1);
  _Pragma("unroll") for(int r=0;r<16;++r)pA1[r]=__builtin_amdgcn_exp2f(pA1[r]);
  WAIT_BAR(0);
  DMA_K(3,0);DMA_V(1,SLOTB);
  ROT();
  kload8(kf,kp0+sl_cur);
  WAIT_BAR(2);
  s16x4 vlo[8],vhi[8]; u32x4 pw0,pw1,pw2,pw3;
  #define PKW(P,B) cvtpk_s(P[B],P[B+1])
  #define PAF(k) __builtin_bit_cast(bf16x8,pw##k)
  #define VFR(i) (bf16x8){vlo[i][0],vlo[i][1],vlo[i][2],vlo[i][3],vhi[i][0],vhi[i][1],vhi[i][2],vhi[i][3]}
  #define PIN(x) asm volatile("":"+v"(x))
  #define MX3(a,b,c) __builtin_fmaxf(__builtin_fmaxf((a),(b)),(c))
  #define GAPA(MF,A0,A1,A2,A3,W0,W1,PW) do{ MF; sacc+=A0; sacc+=A1; sacc+=A2; sacc+=A3; PIN(sacc); W0; W1; PIN(PW); SBAR(); }while(0)
  #define EX(v) __builtin_amdgcn_exp2f(v)
  #define GAPB(MF,X,B) do{ MF; X[B]=EX(X[B]); X[B+1]=EX(X[B+1]); X[B+2]=EX(X[B+2]); X[B+3]=EX(X[B+3]); PIN(X); SBAR(); }while(0)
  #define VRD(i) do{ vlo[i]=vtr(vp_+(((i)>>2)*4096+((i)&3)*1024)); vhi[i]=vtr(vp_+(((i)>>2)*4096+((i)&3)*1024+512)); }while(0)
  #define KRD(G,j) do{ if(G){ kload2(kf,kp0+sl_next,j); SBAR(); } }while(0)
  #define STEP(C0,C1,P0,P1,t,GK,GV,GL) do{ SBAR(); \
    const lds_cptr vp_=vp0+sl_prev; \
    VRD(0); SBAR(); float sacc=(P0[0]+P0[1]); \
    GAPA(C0=__builtin_amdgcn_mfma_f32_32x32x16_bf16(kf[0],qr[0],negm,0,0,0), P0[2],P0[3],P0[4],P0[5],     pw0[0]=PKW(P0,0), pw0[1]=PKW(P0,2), pw0); \
    VRD(4); SBAR(); GAPA(C1=__builtin_amdgcn_mfma_f32_32x32x16_bf16(kf[1],qr[0],negm,0,0,0), P0[6],P0[7],P0[8],P0[9],     pw0[2]=PKW(P0,4), pw0[3]=PKW(P0,6), pw0); \
    VRD(1); SBAR(); GAPA(C0=__builtin_amdgcn_mfma_f32_32x32x16_bf16(kf[2],qr[1],C0,0,0,0),   P0[10],P0[11],P0[12],P0[13], pw1[0]=PKW(P0,8), pw1[1]=PKW(P0,10), pw1); \
    VRD(5); SBAR(); GAPA(C1=__builtin_amdgcn_mfma_f32_32x32x16_bf16(kf[3],qr[1],C1,0,0,0),   P0[14],P0[15],P1[0],P1[1],   pw1[2]=PKW(P0,12),pw1[3]=PKW(P0,14), pw1); \
    VRD(2); SBAR(); GAPA(C0=__builtin_amdgcn_mfma_f32_32x32x16_bf16(kf[4],qr[2],C0,0,0,0),   P1[2],P1[3],P1[4],P1[5],     pw2[0]=PKW(P1,0), pw2[1]=PKW(P1,2), pw2); \
    VRD(6); SBAR(); GAPA(C1=__builtin_amdgcn_mfma_f32_32x32x16_bf16(kf[5],qr[2],C1,0,0,0),   P1[6],P1[7],P1[8],P1[9],     pw2[2]=PKW(P1,4), pw2[3]=PKW(P1,6), pw2); \
    VRD(3); SBAR(); GAPA(C0=__builtin_amdgcn_mfma_f32_32x32x16_bf16(kf[6],qr[3],C0,0,0,0),   P1[10],P1[11],P1[12],P1[13], pw3[0]=PKW(P1,8), pw3[1]=PKW(P1,10), pw3); \
    VRD(7); SBAR(); GAPA(C1=__builtin_amdgcn_mfma_f32_32x32x16_bf16(kf[7],qr[3],C1,0,0,0),   P1[14],P1[15],0.f,0.f,       pw3[2]=PKW(P1,12),pw3[3]=PKW(P1,14), pw3); \
    l_reg+=sacc; \
    if(GK){DMA_K((t)+3,sl_cur);} if(GV){DMA_V((t)+1,sl_next);} \
    CMASK(C0,C1,t); \
    resc=false; if constexpr(!NOMAX){ float a=MX3(C0[0],C0[1],C1[0]),b=MX3(C0[2],C0[3],C1[1]); a=MX3(a,C1[2],C1[3]); \
      _Pragma("unroll") for(int r=4;r<16;r+=4){a=MX3(a,C0[r],C0[r+1]);b=MX3(b,C0[r+2],C0[r+3]);a=MX3(a,C1[r],C1[r+1]);b=MX3(b,C1[r+2],C1[r+3]);} \
      float rm=__builtin_fmaxf(a,b); { auto rr=__builtin_amdgcn_permlane32_swap(__float_as_uint(rm),__float_as_uint(rm),false,false); rm=__builtin_fmaxf(__uint_as_float(rr[0]),__uint_as_float(rr[1])); } \
      resc=false; \
      if(__builtin_expect(__any(rm>(float)THRL),0)){ const float dl=__builtin_fmaxf(rm,0.f); mhat+=dl; \
        _Pragma("unroll") for(int r=0;r<16;++r){C0[r]-=dl;C1[r]-=dl;} \
        _Pragma("unroll") for(int r=0;r<16;++r)negm[r]=-mhat; asm volatile("":"+v"(negm)); \
        const float f=__builtin_amdgcn_exp2f(-dl); l_reg*=f; if(hi==0)wsf[r32]=f; resc=true; } } \
    SBAR(); \
    GAPB(o[0]=__builtin_amdgcn_mfma_f32_32x32x16_bf16(PAF(0),VFR(0),o[0],0,0,0), C0,0); \
    GAPB(o[1]=__builtin_amdgcn_mfma_f32_32x32x16_bf16(PAF(0),VFR(4),o[1],0,0,0), C0,4); \
    KRD(GL,0); GAPB(o[0]=__builtin_amdgcn_mfma_f32_32x32x16_bf16(PAF(1),VFR(1),o[0],0,0,0), C0,8); \
    KRD(GL,1); GAPB(o[1]=__builtin_amdgcn_mfma_f32_32x32x16_bf16(PAF(1),VFR(5),o[1],0,0,0), C0,12); \
    KRD(GL,2); GAPB(o[0]=__builtin_amdgcn_mfma_f32_32x32x16_bf16(PAF(2),VFR(2),o[0],0,0,0), C1,0); \
    KRD(GL,3); GAPB(o[1]=__builtin_amdgcn_mfma_f32_32x32x16_bf16(PAF(2),VFR(6),o[1],0,0,0), C1,4); \
    GAPB(o[0]=__builtin_amdgcn_mfma_f32_32x32x16_bf16(PAF(3),VFR(3),o[0],0,0,0), C1,8); \
    GAPB(o[1]=__builtin_amdgcn_mfma_f32_32x32x16_bf16(PAF(3),VFR(7),o[1],0,0,0), C1,12); \
    }while(0)
  int t=1;
  #undef CMASK
  #define CMASK(P0,P1,t) do{}while(0)
  for(;t+5<NT;t+=2){
    STEP(pB0,pB1,pA0,pA1,t,true,true,true);     WAIT_BAR(2); RESC(); ROT();
    STEP(pA0,pA1,pB0,pB1,t+1,true,true,true);   WAIT_BAR(2); RESC(); ROT();
  }
  #undef CMASK
  #define CMASK(P0,P1,t) do{}while(0)
  #define ENDW(tt) do{ if((tt)+3<NT){WAIT_BAR(2);} else if((tt)+2<NT){WAIT_BAR(1);} else {WAIT_BAR(0);} }while(0)
  for(;t+1<NT;t+=2){
    STEP(pB0,pB1,pA0,pA1,t,(t+3<NT),(t+1<NT),(t+1<NT));       ENDW(t);   RESC(); ROT();
    STEP(pA0,pA1,pB0,pB1,t+1,(t+4<NT),(t+2<NT),(t+2<NT));     ENDW(t+1); RESC(); ROT();
  }
  STEP(pB0,pB1,pA0,pA1,NT-1,false,false,false); RESC();
  { float sacc=pB0[0]+pB0[1]; _Pragma("unroll") for(int r=2;r<16;++r)sacc+=pB0[r]; _Pragma("unroll") for(int r=0;r<16;++r)sacc+=pB1[r]; l_reg+=sacc;
    pw0=(u32x4){PKW(pB0,0),PKW(pB0,2),PKW(pB0,4),PKW(pB0,6)};pw1=(u32x4){PKW(pB0,8),PKW(pB0,10),PKW(pB0,12),PKW(pB0,14)};pw2=(u32x4){PKW(pB1,0),PKW(pB1,2),PKW(pB1,4),PKW(pB1,6)};pw3=(u32x4){PKW(pB1,8),PKW(pB1,10),PKW(pB1,12),PKW(pB1,14)};
    SBAR(); pv(o,vb0+sl_cur,PAF(0),PAF(1),PAF(2),PAF(3)); }
  #undef PKW
  #undef PAF
  #undef VFR
  #undef PIN
  #undef MX3
  #undef GAPA
  #undef GAPB
  #undef EX
  #undef VRD
  #undef KRD
  #undef STEP
  #undef ENDW
  {auto rr=__builtin_amdgcn_permlane32_swap(__float_as_uint(l_reg),__float_as_uint(l_reg),false,false);l_reg=__uint_as_float(rr[0])+__uint_as_float(rr[1]);}
  if(hi==0)wsf[32+r32]=l_reg;asm volatile("s_waitcnt lgkmcnt(0)":::"memory");
  float rli[16];
  #pragma unroll
  for(int r=0;r<16;++r)rli[r]=__builtin_amdgcn_rcpf(wsf[32+crow(r,hi)]);
  bf16*Ow=O+(rowbase+q0+wid*QBLK)*DM+h*D;
  { bf16*stg=(bf16*)(shm+LDS_OST)+wid*2048;
    #pragma unroll
    for(int r=0;r<16;++r){const int orow=crow(r,hi);
      #pragma unroll
      for(int d0=0;d0<2;++d0)stg[orow*64+d0*32+r32]=__float2bfloat16(o[d0][r]*rli[r]);}
    asm volatile("s_waitcnt lgkmcnt(0)":::"memory");
    #pragma unroll
    for(int i=0;i<4;++i){const int row=i*8+(lane>>3),ch=lane&7; const u32x4 v=*(const u32x4*)(stg+row*64+ch*8); ATTN_STORE16(Ow+(long)row*DM+ch*8,v);} }
  asm volatile("s_waitcnt lgkmcnt(0)\n\ts_barrier":::"memory");
  #undef DMA_K
  #undef DMA_V
  #undef CMASK
  #undef START
  #undef RESC
  #undef ROT
}
constexpr int ATTN_LDS_BYTES=LDS_BYTES;
struct AttnTensors { const bf16* Q; const bf16* K; const bf16* V; bf16* O; };
struct AttnUnit { int bh; int qb; };
#undef SBAR
#undef WAIT_BAR
}

#include <hip/hip_cooperative_groups.h>
namespace cg = cooperative_groups;
#define LAS __attribute__((address_space(3)))
typedef unsigned short bf16;
typedef unsigned v4u __attribute__((ext_vector_type(4)));
typedef float f32x4 __attribute__((ext_vector_type(4)));
typedef short bf16x8 __attribute__((ext_vector_type(8)));
constexpr int NWAVES = 8, NTHREADS = 512;
constexpr int BATCH = 4, SEQ = 8192, DM = 1024, M = BATCH * SEQ, DFF = 2816, NIN = 5632, NLAYER = 2;
constexpr size_t MiB = 1u << 20;
constexpr size_t WS_ROWSS = 496 * MiB, WS_CIN = 0, WS_P = 2 * MiB, WS_E = 4 * MiB;
constexpr size_t WS_W1A = 6 * MiB, WS_W2A = 17 * MiB, WS_WIN = 22 * MiB + MiB / 2;
constexpr size_t WS_G2 = 34 * MiB, G2_STRIDE = 23 * MiB, G2_WAO = 0, G2_WRO = 2 * MiB, G2_WOUT = 4 * MiB, G2_W1B = 6 * MiB, G2_W2B = 17 * MiB;
constexpr size_t WS_XB = 80 * MiB, WS_Q = 144 * MiB, WS_K = 208 * MiB, WS_V = 224 * MiB, WS_XR = 240 * MiB, WS_YR = 304 * MiB, WS_GL = 368 * MiB, WS_BAR = 508 * MiB, WS_BAR_BYTES = 16384, WS_END = 508 * MiB + 65536;
constexpr size_t WS_HID = 144 * MiB;
constexpr int LDS_BYTES = 147456;
constexpr float RMS_EPS = 1e-6f;

__device__ __forceinline__ unsigned f2bf(float f) { unsigned u = __builtin_bit_cast(unsigned, f); return (u + 0x7fffu + ((u >> 16) & 1u)) >> 16; }
__device__ __forceinline__ unsigned pk2(float lo, float hi) { return f2bf(lo) | (f2bf(hi) << 16); }
__device__ __forceinline__ float bf2f(unsigned short v) { return __uint_as_float((unsigned)v << 16); }
__device__ __forceinline__ float wave_sum(float v) {
#pragma unroll
    for (int o = 1; o < 64; o <<= 1) v += __shfl_xor(v, o);
    return v;
}
__device__ __forceinline__ void transpose_item(const float* W, int K, int N, bf16* WT, const float* gain, bool w1perm, LAS float* scr, int item, int lane) {
    const int nblk = N / 32, kb = item / nblk, nb = item % nblk, k0 = 64 * kb, n0d = 32 * nb;
    const int n0s = w1perm ? (((n0d & 255) >> 7) * DFF + 128 * (n0d >> 8) + (n0d & 127)) : n0d;
#pragma unroll 8
    for (int i = 0; i < 32; ++i) { const int kk = 2 * i + (lane >> 5); float v = W[(size_t)(k0 + kk) * N + n0s + (lane & 31)]; if (gain) v *= gain[k0 + kk]; scr[kk * 33 + (lane & 31)] = v; }
    asm volatile("s_waitcnt lgkmcnt(0)" ::: "memory");
    const int c = lane & 7;
#pragma unroll
    for (int j = 0; j < 4; ++j) { const int n = (lane >> 3) + 8 * j; const LAS float* s = scr + (8 * c) * 33 + n;
        v4u o; o.x = pk2(s[0 * 33], s[1 * 33]); o.y = pk2(s[2 * 33], s[3 * 33]); o.z = pk2(s[4 * 33], s[5 * 33]); o.w = pk2(s[6 * 33], s[7 * 33]);
        *(v4u*)(WT + (size_t)(n0d + n) * K + k0 + 8 * c) = o; }
    asm volatile("s_waitcnt lgkmcnt(0)" ::: "memory");
}
__device__ __forceinline__ void convert_matrix(const float* W, int K, int N, bf16* WT, const float* gain, bool w1perm, LAS float* scr, int gw, int ngw, int lane) {
    const int nitems = (K / 64) * (N / 32);
    for (int it = gw; it < nitems; it += ngw) transpose_item(W, K, N, WT, gain, w1perm, scr, it, lane);
}
struct Params { const float* in[22]; float* out; unsigned char* ws; };
enum { I_X = 0, I_F1N, I_F1W1, I_F1W2, I_MIXN, I_WIN, I_BGATE, I_QN, I_KN, I_WAO, I_CONVW, I_CONVB, I_WA, I_BA, I_WX, I_BX, I_LAM, I_WRO, I_WOUT, I_F2N, I_F2W1, I_F2W2 };

__device__ __forceinline__ void convert_group1(const Params& p, int l, LAS float* scr, int gw, int ngw, int lane) {
    convert_matrix(p.in[I_F1W1] + (size_t)l * DM * NIN, DM, NIN, (bf16*)(p.ws + WS_W1A), p.in[I_F1N] + l * DM, true, scr, gw, ngw, lane);
    convert_matrix(p.in[I_F1W2] + (size_t)l * DFF * DM, DFF, DM, (bf16*)(p.ws + WS_W2A), nullptr, false, scr, gw, ngw, lane);
    convert_matrix(p.in[I_WIN] + (size_t)l * DM * NIN, DM, NIN, (bf16*)(p.ws + WS_WIN), p.in[I_MIXN] + l * DM, false, scr, gw, ngw, lane);
}
__device__ __forceinline__ void convert_group2(const Params& p, int l, LAS float* scr, int gw, int ngw, int lane) {
    unsigned char* g2 = p.ws + WS_G2 + (size_t)l * G2_STRIDE;
    convert_matrix(p.in[I_WAO] + (size_t)l * DM * DM, DM, DM, (bf16*)(g2 + G2_WAO), nullptr, false, scr, gw, ngw, lane);
    convert_matrix(p.in[I_WRO] + (size_t)l * DM * DM, DM, DM, (bf16*)(g2 + G2_WRO), nullptr, false, scr, gw, ngw, lane);
    convert_matrix(p.in[I_WOUT] + (size_t)l * DM * DM, DM, DM, (bf16*)(g2 + G2_WOUT), nullptr, false, scr, gw, ngw, lane);
    convert_matrix(p.in[I_F2W1] + (size_t)l * DM * NIN, DM, NIN, (bf16*)(g2 + G2_W1B), p.in[I_F2N] + l * DM, true, scr, gw, ngw, lane);
    convert_matrix(p.in[I_F2W2] + (size_t)l * DFF * DM, DFF, DM, (bf16*)(g2 + G2_W2B), nullptr, false, scr, gw, ngw, lane);
}
__device__ __forceinline__ void x_rows(const float* x, bf16* xb, float* rowss, int gw, int ngw, int lane) {
    for (int m = gw; m < M; m += ngw) {
        const f32x4* xr = (const f32x4*)(x + (size_t)m * DM) + lane; f32x4 v[4]; float s = 0.f;
#pragma unroll
        for (int j = 0; j < 4; ++j) { v[j] = xr[64 * j]; s += (v[j].x * v[j].x + v[j].y * v[j].y) + (v[j].z * v[j].z + v[j].w * v[j].w); }
        s = wave_sum(s);
        unsigned long long* o8 = (unsigned long long*)(xb + (size_t)m * DM) + lane;
#pragma unroll
        for (int j = 0; j < 4; ++j) o8[64 * j] = (unsigned long long)pk2(v[j].x, v[j].y) | ((unsigned long long)pk2(v[j].z, v[j].w) << 32);
        if (lane < 16) rowss[(size_t)m * 16 + lane] = (lane == 0) ? s : 0.f;
    }
}
__device__ __forceinline__ void qk_rope(bf16* q, bf16* k, const float* qn, const float* kn, int gtid, int nthreads) {
    const int total = M * 4 * 4;
    for (int it = gtid; it < total; it += nthreads) {
        const int q4 = it & 3, th = it >> 2, hh = 16 + (th & 3), tok = th >> 2, half = q4 >> 1, sub = q4 & 1;
        bf16* p = (hh < 16) ? q + (size_t)tok * 1024 + hh * 64 : k + (size_t)tok * 256 + (hh - 16) * 64;
        const float* gn = (hh < 16) ? qn : kn; const float osc = (hh < 16) ? attn_body::C2 : 1.0f;
        bf16* p2;
        if (hh < 16) { p += 32 * half + 8 * sub; p2 = p + 16; }
        else { const int kvh = hh - 16, bb = tok >> 13, sq = tok & 8191, tt = sq >> 6, rr = sq & 63;
               bf16* kb = k + ((size_t)(bb * 4 + kvh) * 128 + tt) * 4096 + rr * 8; p = kb + (4 * half + sub) * 512; p2 = kb + (4 * half + sub + 2) * 512; }
        const v4u w1 = *(const v4u*)p, w2 = *(const v4u*)p2;
        float x1[8], x2[8];
        x1[0] = __uint_as_float(w1.x << 16); x1[1] = __uint_as_float(w1.x & 0xffff0000u); x1[2] = __uint_as_float(w1.y << 16); x1[3] = __uint_as_float(w1.y & 0xffff0000u);
        x1[4] = __uint_as_float(w1.z << 16); x1[5] = __uint_as_float(w1.z & 0xffff0000u); x1[6] = __uint_as_float(w1.w << 16); x1[7] = __uint_as_float(w1.w & 0xffff0000u);
        x2[0] = __uint_as_float(w2.x << 16); x2[1] = __uint_as_float(w2.x & 0xffff0000u); x2[2] = __uint_as_float(w2.y << 16); x2[3] = __uint_as_float(w2.y & 0xffff0000u);
        x2[4] = __uint_as_float(w2.z << 16); x2[5] = __uint_as_float(w2.z & 0xffff0000u); x2[6] = __uint_as_float(w2.w << 16); x2[7] = __uint_as_float(w2.w & 0xffff0000u);
        float ss = 0.f;
#pragma unroll
        for (int i = 0; i < 8; ++i) ss += x1[i] * x1[i] + x2[i] * x2[i];
        ss += __shfl_xor(ss, 1); ss += __shfl_xor(ss, 2);
        const float rs = __builtin_amdgcn_rsqf(ss * (1.0f / 64.0f) + RMS_EPS);
        const int s = tok & (SEQ - 1); const float pos = (float)(half ? (s & 63) : (s >> 6));
        float o1[8], o2[8];
#pragma unroll
        for (int i = 0; i < 8; ++i) { const int ii = 8 * sub + i; const float inv = exp2f(-(float)ii * 0.83048202372184f);
            const float ang = pos * inv, c = __cosf(ang), sn = __sinf(ang);
            const float a = x1[i] * rs * gn[32 * half + ii], b = x2[i] * rs * gn[32 * half + 16 + ii];
            o1[i] = (a * c - b * sn) * osc; o2[i] = (b * c + a * sn) * osc; }
        v4u r1, r2; r1.x = pk2(o1[0], o1[1]); r1.y = pk2(o1[2], o1[3]); r1.z = pk2(o1[4], o1[5]); r1.w = pk2(o1[6], o1[7]);
        r2.x = pk2(o2[0], o2[1]); r2.y = pk2(o2[2], o2[3]); r2.z = pk2(o2[4], o2[5]); r2.w = pk2(o2[6], o2[7]);
        *(v4u*)p = r1; *(v4u*)p2 = r2;
    }
}
constexpr int RL = 128, NCH = SEQ / RL, XCF_STRIDE = 68, XCB_STRIDE = 72, NIT = BATCH * NCH * 16;
constexpr int RNN_XCF = 0, RNN_XCB = RL * XCF_STRIDE * 4, RNN_HS = RNN_XCB + RL * XCB_STRIDE * 2;
__device__ __forceinline__ void rnn_carry(const float* Pb, const float* Eb, float* CIN, int gtid, int nthreads) {
    for (int sq = gtid; sq < BATCH * 2 * 1024; sq += nthreads) {
        const int ch = sq & 1023, d = (sq >> 10) & 1, b = sq >> 11; float carry = 0.f;
        for (int k0 = 0; k0 < NCH; k0 += 8) { float pv[8], ev[8];
#pragma unroll
            for (int u = 0; u < 8; ++u) { const int jj = d ? NCH - 1 - (k0 + u) : k0 + u; const size_t ix = ((size_t)(b * NCH + jj) * 2 + d) * 1024 + ch; pv[u] = Pb[ix]; ev[u] = Eb[ix]; }
#pragma unroll
            for (int u = 0; u < 8; ++u) { const int jj = d ? NCH - 1 - (k0 + u) : k0 + u; const size_t ix = ((size_t)(b * NCH + jj) * 2 + d) * 1024 + ch; CIN[ix] = carry; carry = pv[u] * carry + ev[u]; } }
    }
}
#define RNN_LOAD_XR(IT, DST) do { const int n_ = (IT) & 15, j_ = ((IT) >> 4) & (NCH - 1), b_ = (IT) >> 10; const int s0_ = j_ * RL + tr * 16 - 2; \
        const bf16* src_ = xr + (size_t)b_ * SEQ * 1024 + 64 * n_ + c; \
        _Pragma("unroll") for (int k_ = 0; k_ < 19; ++k_) { const int s_ = s0_ + k_; DST[k_] = (s_ >= 0 && s_ < SEQ) ? src_[(size_t)s_ * 1024] : (unsigned short)0; } } while (0)
template <int PASS> __device__ __forceinline__ void rnn_pass(LAS unsigned char* lds, const bf16* xr, bf16* yr, bf16* yout, float* Pb, float* Eb, const float* CIN, const float* conv_w, const float* conv_b,
        const float* wa, const float* ba, const float* wx, const float* bxp, const float* lam, int bxid, int G) {
    const int tid = otid(), lane = tid & 63, wid = __builtin_amdgcn_readfirstlane(tid >> 6), d = wid & 1, cs = wid >> 1, fr = lane & 15, fq = lane >> 4;
    const int c = tid & 63, tr = tid >> 6;
    LAS float* XCF = (LAS float*)(lds + RNN_XCF); LAS unsigned short* XCB = (LAS unsigned short*)(lds + RNN_XCB); LAS float* HS = (LAS float*)(lds + RNN_HS);
    const int o = d ? 3 - fq : fq, tot_lane = fr + (d ? 0 : 48);
    int n_cur = -1; bf16x8 bwa[2], bwx[2]; float bav = 0.f, bxv = 0.f, sp8 = 0.f;
    bwa[0] = bwa[1] = bwx[0] = bwx[1] = (bf16x8){0, 0, 0, 0, 0, 0, 0, 0};
    unsigned short xcur[19], xnxt[19];
    if (bxid < NIT) RNN_LOAD_XR(bxid, xcur);
    for (int it = bxid; it < NIT; it += G) {
        const int n = it & 15, j = (it >> 4) & (NCH - 1), b = it >> 10;
        if (it + G < NIT) RNN_LOAD_XR(it + G, xnxt);
        {
            const int chc = 64 * n + c;
            const float cw0 = conv_w[chc], cw1 = conv_w[1024 + chc], cw2 = conv_w[2048 + chc], cw3 = conv_w[3072 + chc], cb = conv_b[chc];
#pragma unroll
            for (int k = 0; k < 16; ++k) { const float xc = cb + cw0 * bf2f(xcur[k]) + cw1 * bf2f(xcur[k + 1]) + cw2 * bf2f(xcur[k + 2]) + cw3 * bf2f(xcur[k + 3]);
                XCF[(tr * 16 + k) * XCF_STRIDE + c] = xc; XCB[(tr * 16 + k) * XCB_STRIDE + c] = (unsigned short)f2bf(xc); }
        }
        const int ch = 64 * n + 16 * cs + fr;
        if (n != n_cur) { n_cur = n;
            const float* wap = wa + ((size_t)(d * 16 + n) * 64) * 64 + 16 * cs + fr; const float* wxp = wx + ((size_t)(d * 16 + n) * 64) * 64 + 16 * cs + fr;
#pragma unroll
            for (int s = 0; s < 2; ++s)
#pragma unroll
                for (int jj = 0; jj < 8; ++jj) { const int kk = 32 * s + 8 * fq + jj; bwa[s][jj] = (short)f2bf(wap[kk * 64]); bwx[s][jj] = (short)f2bf(wxp[kk * 64]); }
            bav = ba[d * 1024 + ch]; bxv = bxp[d * 1024 + ch]; sp8 = -8.0f * log1pf(__expf(-lam[d * 1024 + ch])); }
        float carry = 0.f, Pacc = 1.f;
        if (PASS == 3) carry = CIN[((size_t)(b * NCH + j) * 2 + d) * 1024 + ch];
        v4u gy[2] = {(v4u){0u, 0u, 0u, 0u}, (v4u){0u, 0u, 0u, 0u}};
        if (PASS == 3) {
#pragma unroll
            for (int qq = 0; qq < 2; ++qq) { const int w = tid + NTHREADS * qq, t = w >> 3, c8 = (w & 7) * 8; gy[qq] = *(const v4u*)(yr + ((size_t)b * SEQ + j * RL + t) * 1024 + 64 * n + c8); } }
        __syncthreads();
        float av[8][4], uv[8][4], At[8], Ut[8], Ae[8], Ue[8];
#pragma unroll
        for (int tq = 0; tq < RL / 16; ++tq) {
            const int t0 = 16 * (d ? (RL / 16 - 1 - tq) : tq);
            const LAS unsigned char* ap = (const LAS unsigned char*)XCB + (t0 + fr) * (XCB_STRIDE * 2) + fq * 16;
            const bf16x8 a0 = *(const LAS bf16x8*)ap, a1 = *(const LAS bf16x8*)(ap + 64);
            f32x4 pa = (f32x4){0.f, 0.f, 0.f, 0.f}, px = (f32x4){0.f, 0.f, 0.f, 0.f};
            pa = __builtin_amdgcn_mfma_f32_16x16x32_bf16(a0, bwa[0], pa, 0, 0, 0); pa = __builtin_amdgcn_mfma_f32_16x16x32_bf16(a1, bwa[1], pa, 0, 0, 0);
            px = __builtin_amdgcn_mfma_f32_16x16x32_bf16(a0, bwx[0], px, 0, 0, 0); px = __builtin_amdgcn_mfma_f32_16x16x32_bf16(a1, bwx[1], px, 0, 0, 0);
#pragma unroll
            for (int i = 0; i < 4; ++i) { const float xc = XCF[(t0 + 4 * fq + i) * XCF_STRIDE + 16 * cs + fr];
                const float r = pg8::fsigmoid(pa[i] + bav), ig = pg8::fsigmoid(px[i] + bxv), la = sp8 * r, a = __expf(la), x2 = 2.0f * la;
                const float mm = (x2 > -0.02f) ? -x2 * (1.0f + x2 * (0.5f + x2 * (0.16666667f + x2 * 0.041666667f))) : 1.0f - a * a;
                av[tq][i] = a; uv[tq][i] = __builtin_amdgcn_sqrtf(mm) * ig * xc; }
            float A = 1.f, U = 0.f;
#pragma unroll
            for (int s = 0; s < 4; ++s) { const int i = d ? 3 - s : s; U = av[tq][i] * U + uv[tq][i]; A *= av[tq][i]; }
            { const float Ap = d ? __shfl_down(A, 16) : __shfl_up(A, 16), Up = d ? __shfl_down(U, 16) : __shfl_up(U, 16); if (o >= 1) { U = A * Up + U; A = A * Ap; } }
            { const float Ap = d ? __shfl_down(A, 32) : __shfl_up(A, 32), Up = d ? __shfl_down(U, 32) : __shfl_up(U, 32); if (o >= 2) { U = A * Up + U; A = A * Ap; } }
            At[tq] = __shfl(A, tot_lane); Ut[tq] = __shfl(U, tot_lane);
            if (PASS == 3) { float e0 = d ? __shfl_down(A, 16) : __shfl_up(A, 16), e1 = d ? __shfl_down(U, 16) : __shfl_up(U, 16); if (o == 0) { e0 = 1.f; e1 = 0.f; } Ae[tq] = e0; Ue[tq] = e1; }
        }
#pragma unroll
        for (int tq = 0; tq < RL / 16; ++tq) {
            const int t0 = 16 * (d ? (RL / 16 - 1 - tq) : tq);
            if (PASS == 3) { float h = Ae[tq] * carry + Ue[tq];
#pragma unroll
                for (int s = 0; s < 4; ++s) { const int i = d ? 3 - s : s; h = av[tq][i] * h + uv[tq][i]; HS[d * (RL * XCF_STRIDE) + (t0 + 4 * fq + i) * XCF_STRIDE + 16 * cs + fr] = h; } }
            carry = At[tq] * carry + Ut[tq]; Pacc *= At[tq];
        }
        if (PASS == 1) { if (fq == 0) { const size_t ix = ((size_t)(b * NCH + j) * 2 + d) * 1024 + ch; Pb[ix] = Pacc; Eb[ix] = carry; } }
        if (PASS == 3) {
            __syncthreads();
#pragma unroll
            for (int qq = 0; qq < 2; ++qq) { const int w = tid + NTHREADS * qq, t = w >> 3, c8 = (w & 7) * 8;
                const LAS float* h0 = HS + t * XCF_STRIDE + c8; const LAS float* h1 = h0 + RL * XCF_STRIDE;
                bf16* yp = yr + ((size_t)b * SEQ + j * RL + t) * 1024 + 64 * n + c8; const v4u g = gy[qq];
                float hv[8];
#pragma unroll
                for (int e = 0; e < 8; ++e) hv[e] = h0[e] + h1[e];
                v4u ov; ov.x = pk2(hv[0] * pg8::bf_lo(g.x), hv[1] * pg8::bf_hi(g.x)); ov.y = pk2(hv[2] * pg8::bf_lo(g.y), hv[3] * pg8::bf_hi(g.y));
                ov.z = pk2(hv[4] * pg8::bf_lo(g.z), hv[5] * pg8::bf_hi(g.z)); ov.w = pk2(hv[6] * pg8::bf_lo(g.w), hv[7] * pg8::bf_hi(g.w));
                *(v4u*)(yout + (yp - yr)) = ov; }
        }
        __syncthreads();
#pragma unroll
        for (int k = 0; k < 19; ++k) xcur[k] = xnxt[k];
    }
}

#define XB_TMO      128
#define XB_XCNT(j)  (256  + 64 * (j))
#define XB_XSUB(j)  (1280 + 64 * (j))
#define XB_XGEN(j)  (2304 + 64 * (j))
#define XB_TOP      3328
#define XB_TOPGEN   3392
#define XCD_BAR_WORDS 3456
#define XB_SPIN_CAP (1u << 18)

__device__ __forceinline__ unsigned xb_ld(unsigned* p)              { return __hip_atomic_load(p, __ATOMIC_RELAXED, __HIP_MEMORY_SCOPE_AGENT); }
__device__ __forceinline__ unsigned xb_add(unsigned* p, unsigned v) { return __hip_atomic_fetch_add(p, v, __ATOMIC_RELAXED, __HIP_MEMORY_SCOPE_AGENT); }
__device__ __forceinline__ unsigned xb_xcc_id() { return (unsigned)__builtin_amdgcn_s_getreg((3 << 11) | 20) & 0xFu; }
#define XB_SPIN(cond, bar) do { unsigned _sp = 0; while (cond) { __builtin_amdgcn_s_sleep(1); \
    if ((++_sp & 255u) == 0u) { if (xb_ld(&(bar)[XB_TMO])) break; if (_sp > XB_SPIN_CAP) { atomicAdd(&(bar)[XB_TMO], 1u); break; } } } } while (0)

struct XcdBarrier {
    unsigned* bar; unsigned x;
    volatile LAS unsigned* st;
};

__device__ __forceinline__ XcdBarrier xcd_barrier_post(unsigned* bar, volatile LAS unsigned* st) {
    XcdBarrier b; b.bar = bar; b.x = xb_xcc_id(); b.st = st;
    if (threadIdx.x == 0) { const unsigned r = xb_add(&bar[XB_XCNT(b.x)], 1u); st[2] = r; st[3] = b.x; }
    return b;
}
__device__ __forceinline__ void xcd_barrier_complete(unsigned* bar, unsigned x, unsigned& nloc, unsigned& nx) {
    const unsigned G = gridDim.x * gridDim.y * gridDim.z;
    unsigned sum, cnt, mine, sp = 0u;
    for (;;) {
        sum = 0u; cnt = 0u; mine = 0u;
#pragma unroll
        for (unsigned j = 0; j < 16; ++j) { const unsigned c = xb_ld(&bar[XB_XCNT(j)]); sum += c; cnt += (c > 0u) ? 1u : 0u; mine = (j == x) ? c : mine; }
        if (sum == G) break;
        __builtin_amdgcn_s_sleep(1);
        if ((++sp & 255u) == 0u) { if (xb_ld(&bar[XB_TMO])) break; if (sp > XB_SPIN_CAP) { atomicAdd(&bar[XB_TMO], 1u); break; } }
    }
    nloc = mine > 0u ? mine : 1u; nx = cnt > 0u ? cnt : 1u;
}

__device__ __forceinline__ void xcd_barrier(const XcdBarrier& b) {
    asm volatile("s_waitcnt vmcnt(0)" ::: "memory");
    __syncthreads();
    if (threadIdx.x == 0) {
        unsigned* bar = b.bar;
        __builtin_amdgcn_s_waitcnt(0);
        unsigned nloc = b.st[0], nx = b.st[1];
        if (nloc == 0u) { xcd_barrier_complete(bar, b.x, nloc, nx); b.st[0] = nloc; b.st[1] = nx; }
        const unsigned old = xb_add(&bar[XB_XSUB(b.x)], 1u);
        const unsigned gen = old / nloc;
        if (old + 1u == (gen + 1u) * nloc) {
            __builtin_amdgcn_fence(__ATOMIC_RELEASE, "agent");
            asm volatile("s_waitcnt vmcnt(0)" ::: "memory");
            const unsigned og = xb_add(&bar[XB_TOP], 1u);
            const unsigned tg = og / nx;
            if (og + 1u == (tg + 1u) * nx) xb_add(&bar[XB_TOPGEN], 1u);
            else XB_SPIN(xb_ld(&bar[XB_TOPGEN]) == tg, bar);
            __builtin_amdgcn_fence(__ATOMIC_ACQUIRE, "agent");
            xb_add(&bar[XB_XGEN(b.x)], 1u);
            asm volatile("s_waitcnt vmcnt(0)" ::: "memory");
        } else {
            XB_SPIN(xb_ld(&bar[XB_XGEN(b.x)]) == gen, bar);
            __builtin_amdgcn_fence(__ATOMIC_ACQUIRE, "agent");
            asm volatile("s_waitcnt vmcnt(0)" ::: "memory");
        }
    }
    __syncthreads();
}

#define CG_SYNC() do { asm volatile("s_waitcnt vmcnt(0) lgkmcnt(0)" ::: "memory"); grid.sync(); __builtin_amdgcn_fence(__ATOMIC_ACQUIRE, "agent"); asm volatile("s_waitcnt vmcnt(0)" ::: "memory"); } while (0)
#define GRID_SYNC() do { asm volatile("s_waitcnt lgkmcnt(0)" ::: "memory"); xcd_barrier(xbar); } while (0)
__global__ void __launch_bounds__(NTHREADS, 2) mega_fwd(Params p) {
    extern __shared__ __attribute__((aligned(16))) unsigned char lds_raw[];
    cg::grid_group grid = cg::this_grid();
    LAS unsigned char* lds = (LAS unsigned char*)lds_raw;
    const int G = gridDim.x, bx = blockIdx.x;
    volatile LAS unsigned* bst = (volatile LAS unsigned*)(lds + 131072 + 64);
    if (threadIdx.x < 2) bst[threadIdx.x] = 0u;
    __syncthreads();
    const XcdBarrier xbar = xcd_barrier_post((unsigned*)(p.ws + WS_BAR), bst);
    unsigned char* ws = p.ws;
    float* rowss = (float*)(ws + WS_ROWSS);
    bf16* XB = (bf16*)(ws + WS_XB); bf16* QB = (bf16*)(ws + WS_Q); bf16* KB = (bf16*)(ws + WS_K); bf16* VB = (bf16*)(ws + WS_V);
    bf16* XR = (bf16*)(ws + WS_XR); bf16* YR = (bf16*)(ws + WS_YR); bf16* GL = (bf16*)(ws + WS_GL); bf16* HID = (bf16*)(ws + WS_HID); bf16* MERGED = XR;
    float* Pb = (float*)(ws + WS_P); float* Eb = (float*)(ws + WS_E); float* CINb = (float*)(ws + WS_CIN);
#define PH_IDS() const int tid = otid(), lane = tid & 63, wave = __builtin_amdgcn_readfirstlane(tid >> 6), gw = bx * NWAVES + wave, ngw = G * NWAVES; LAS float* scr = (LAS float*)(lds + wave * 16384); (void)lane; (void)gw; (void)ngw; (void)scr

    { PH_IDS();
      convert_group1(p, 0, scr, gw, ngw, lane);
      convert_group2(p, 0, scr, gw, ngw, lane);
      convert_group2(p, 1, scr, gw, ngw, lane);
      x_rows(p.in[I_X], XB, rowss, gw, ngw, lane);
      (void)tid; }
    GRID_SYNC();
    if (p.ws == nullptr) CG_SYNC();
    int vbx_ = bx;
    { unsigned ok = (G % 8 == 0) ? 1u : 0u, nz = 0u, slot = 0u; const unsigned myx = bst[3], rank = bst[2]; unsigned* barw = (unsigned*)(p.ws + WS_BAR);
#pragma unroll
      for (unsigned j = 0; j < 16; ++j) { const unsigned c = xb_ld(&barw[XB_XCNT(j)]); if (c) { if (c != (unsigned)G / 8u) ok = 0u; if (j < myx) ++slot; ++nz; } }
      if (nz != 8u) ok = 0u;
      if (ok) vbx_ = (int)(rank * 8u + slot); }
    const int vbx = __builtin_amdgcn_readfirstlane(vbx_);

#pragma unroll 1
    for (int l = 0; l < NLAYER; ++l) {
        unsigned char* g2 = ws + WS_G2 + (size_t)l * G2_STRIDE;
        float* rs_ffn1 = rowss + (size_t)(3 * l + 0) * M * 16; float* rs_mix = rowss + (size_t)(3 * l + 1) * M * 16; float* rs_ffn2 = rowss + (size_t)(3 * l + 2) * M * 16;
        { pg8::Gemm g{XB, (const bf16*)(ws + WS_W1A), M, NIN, DM}; pg8::StaticOrder S; S.init(M, NIN, G, vbx);
          pg8::EpiSwiglu E{HID, rs_ffn1, DFF}; pg8::gemm_phase<pg8::EpiSwiglu, pg8::StaticOrder, true, true>(lds, g, S, E); }
        GRID_SYNC();
        { pg8::Gemm g{HID, (const bf16*)(ws + WS_W2A), M, DM, DFF}; pg8::StaticOrder S; S.init(M, DM, G, vbx);
          pg8::EpiResid E{XB, nullptr, rs_mix, 0.5f}; pg8::gemm_phase<pg8::EpiResid, pg8::StaticOrder, true, true, true>(lds, g, S, E); }
        GRID_SYNC();
        { pg8::Gemm g{XB, (const bf16*)(ws + WS_WIN), M, NIN, DM}; pg8::StaticOrder S; S.init(M, NIN, G, vbx);
          pg8::EpiIn E{QB, KB, VB, XR, YR, GL, rs_mix, p.in[I_BGATE] + l * 2048}; pg8::gemm_phase<pg8::EpiIn, pg8::StaticOrder, true, true>(lds, g, S, E); }
        GRID_SYNC();
        { PH_IDS(); qk_rope(QB, KB, p.in[I_QN] + l * 64, p.in[I_KN] + l * 64, bx * NTHREADS + tid, G * NTHREADS); }
        rnn_pass<1>(lds, XR, YR, YR, Pb, Eb, CINb, p.in[I_CONVW] + l * 4096, p.in[I_CONVB] + l * 1024, p.in[I_WA] + (size_t)l * 131072, p.in[I_BA] + l * 2048,
                    p.in[I_WX] + (size_t)l * 131072, p.in[I_BX] + l * 2048, p.in[I_LAM] + l * 2048, vbx, G);
        if (l + 1 < NLAYER) { PH_IDS(); convert_group1(p, l + 1, scr, gw, ngw, lane); }
        GRID_SYNC();
        { PH_IDS(); rnn_carry(Pb, Eb, CINb, bx * NTHREADS + tid, G * NTHREADS); }
        GRID_SYNC();
        {
            const int nun = BATCH * 16 * 32;
            bool nomax;
            { const int l64 = otid() & 63; float gq = __builtin_fabsf(p.in[I_QN][l * 64 + l64]), gk = __builtin_fabsf(p.in[I_KN][l * 64 + l64]);
#pragma unroll
              for (int o = 1; o < 64; o <<= 1) { gq = __builtin_fmaxf(gq, __shfl_xor(gq, o)); gk = __builtin_fmaxf(gk, __shfl_xor(gk, o)); }
              nomax = __builtin_amdgcn_readfirstlane((11.6f * gq * gk <= 64.0f) ? 1 : 0) != 0; }
            for (int i = 0; i * G + vbx < nun; ++i) {
                int b, h, qb;
                if (G == 256) { const int xcd = vbx & 7, idx = vbx >> 3, pair = xcd * 2 + (i >> 2); b = pair >> 2; h = (pair & 3) * 4 + (i & 3); qb = idx; }
                else { const int uid = i * G + vbx; qb = uid & 31; h = (uid >> 5) & 15; b = uid >> 9; }
                if (nomax) attn_body::attn_unit<8, true>(b, h, qb, (const attn_body::bf16*)QB, (const attn_body::bf16*)KB, (const attn_body::bf16*)VB, (attn_body::bf16*)QB, (char*)lds_raw, p.in[I_QN] + l * 64);
                else attn_body::attn_unit<8, false>(b, h, qb, (const attn_body::bf16*)QB, (const attn_body::bf16*)KB, (const attn_body::bf16*)VB, (attn_body::bf16*)QB, (char*)lds_raw, p.in[I_QN] + l * 64);
            }
            __syncthreads();
        }
        rnn_pass<3>(lds, XR, YR, YR, Pb, Eb, CINb, p.in[I_CONVW] + l * 4096, p.in[I_CONVB] + l * 1024, p.in[I_WA] + (size_t)l * 131072, p.in[I_BA] + l * 2048,
                    p.in[I_WX] + (size_t)l * 131072, p.in[I_BX] + l * 2048, p.in[I_LAM] + l * 2048, vbx, G);
        GRID_SYNC();
        { pg8::Gemm g{QB, (const bf16*)(g2 + G2_WAO), M, DM, DM}; pg8::StaticOrder S; S.init(M, DM, G, vbx);
          pg8::EpiGate<false> E{MERGED, GL, 0}; pg8::gemm_phase<pg8::EpiGate<false>, pg8::StaticOrder, true, true>(lds, g, S, E); }
        { pg8::Gemm g{YR, (const bf16*)(g2 + G2_WRO), M, DM, DM}; pg8::StaticOrder S; S.init(M, DM, G, vbx);
          pg8::EpiGate<true> E{MERGED, GL, 1024}; pg8::gemm_phase<pg8::EpiGate<true>, pg8::StaticOrder, true, true>(lds, g, S, E); }
        GRID_SYNC();
        { pg8::Gemm g{MERGED, (const bf16*)(g2 + G2_WOUT), M, DM, DM}; pg8::StaticOrder S; S.init(M, DM, G, vbx);
          pg8::EpiResid E{XB, nullptr, rs_ffn2, 1.0f}; pg8::gemm_phase<pg8::EpiResid, pg8::StaticOrder, true, true>(lds, g, S, E); }
        GRID_SYNC();
        { pg8::Gemm g{XB, (const bf16*)(g2 + G2_W1B), M, NIN, DM}; pg8::StaticOrder S; S.init(M, NIN, G, vbx);
          pg8::EpiSwiglu E{HID, rs_ffn2, DFF}; pg8::gemm_phase<pg8::EpiSwiglu, pg8::StaticOrder, true, true>(lds, g, S, E); }
        GRID_SYNC();
        { pg8::Gemm g{HID, (const bf16*)(g2 + G2_W2B), M, DM, DFF}; pg8::StaticOrder S; S.init(M, DM, G, vbx);
          const bool lastl = (l + 1 == NLAYER);
          pg8::EpiResid E{XB, lastl ? p.out : nullptr, lastl ? nullptr : rowss + (size_t)(3 * (l + 1)) * M * 16, 0.5f}; pg8::gemm_phase<pg8::EpiResid, pg8::StaticOrder, true, true, true>(lds, g, S, E); }
        if (l + 1 < NLAYER) GRID_SYNC();
    }
}

extern "C" void kernel_launch(void* const* d_in, const int* in_sizes, int n_in, void* d_out, int out_size, void* d_ws, size_t ws_size, hipStream_t stream) {
    static int grid = 0;
    if (grid == 0) {
        if (n_in != 22 || out_size != M * DM || ws_size < WS_END) { fprintf(stderr, "kernel_launch: unexpected shapes (n_in %d out %d ws %zu)\n", n_in, out_size, ws_size); grid = -1; return; }
        int dev = 0, cus = 0, per_cu = 0;
        hipGetDevice(&dev); hipDeviceGetAttribute(&cus, hipDeviceAttributeMultiprocessorCount, dev);
        hipFuncSetAttribute((const void*)mega_fwd, hipFuncAttributeMaxDynamicSharedMemorySize, LDS_BYTES);
        hipOccupancyMaxActiveBlocksPerMultiprocessor(&per_cu, (const void*)mega_fwd, NTHREADS, LDS_BYTES);
        if (per_cu < 1) { fprintf(stderr, "kernel_launch: occupancy query says %d blocks per CU\n", per_cu); per_cu = 1; }
        (void)hipGetLastError();
        grid = cus;
    }
    if (grid < 0) return;
    if (hipMemsetAsync((char*)d_ws + WS_BAR, 0, WS_BAR_BYTES, stream) != hipSuccess) { fprintf(stderr, "kernel_launch: memset of the barrier words failed\n"); return; }
    Params p{};
    for (int i = 0; i < 22; ++i) p.in[i] = (const float*)d_in[i];
    p.out = (float*)d_out; p.ws = (unsigned char*)d_ws;
    void* args[] = {&p};
    hipError_t e = hipLaunchCooperativeKernel((const void*)mega_fwd, dim3(grid), dim3(NTHREADS), args, LDS_BYTES, stream);
    if (e != hipSuccess) fprintf(stderr, "cooperative launch failed: %s (grid %d)\n", hipGetErrorString(e), grid);
}
```

```cpp
#include <hip/hip_runtime.h>
#include <cstdio>
#include <cstdint>

__device__ __forceinline__ int otid() { int t = threadIdx.x; asm volatile("" : "+v"(t)); return t; }
namespace pg8 {
#define PG8_LAS __attribute__((address_space(3)))
typedef unsigned short bf16_t;
typedef short bf16x8 __attribute__((ext_vector_type(8)));
typedef float f32x4 __attribute__((ext_vector_type(4)));
typedef unsigned u32x4 __attribute__((ext_vector_type(4)));
constexpr int BM = 256, BK = 64, HALF = 128, HTB = HALF * BK * 2  , STAGE_BYTES = 8 * HTB, NXCD = 8, WGM = 8;

__host__ __device__ __forceinline__ int lds_byte(int r, int c) { const int st = (r >> 4) * 2 + (c >> 5), rr = r & 15, cc = c & 31, ob = rr * 64 + cc * 2; return st * 1024 + (ob ^ (((ob >> 9) & 1) << 5)); }
__host__ __device__ __forceinline__ void stage_rc(int b, int& R, int& C) { const int st = b / 1024, sb = b % 1024, swz = sb ^ (((sb >> 9) & 1) << 5); R = (st >> 1) * 16 + swz / 64; C = (st & 1) * 32 + (swz % 64) / 2; }
__host__ __device__ __forceinline__ int perm32(int rho) { const int n = rho >> 4, i = rho & 15; return 8 * (i >> 2) + 4 * n + (i & 3); }

struct Unit { int pm, pn; };
struct Gemm { const bf16_t* A; const bf16_t* Bt; int M, N, K; };

struct StaticOrder {
    int nM, nN, nwg, G, c;
    __host__ __device__ void init(int M, int N, int G_, int c_) { nM = M / BM; nN = N / BM; nwg = nM * nN; G = G_; c = c_; }
    __host__ __device__ bool next(int i, Unit& u) const {
        const long L = (long)i * G + c; if (L >= nwg) return false;
        int wgid = (int)L; { const int q = nwg / NXCD, r = nwg % NXCD, xcd = wgid % NXCD, off = wgid / NXCD; wgid = (xcd < r ? xcd * (q + 1) : r * (q + 1) + (xcd - r) * q) + off; }
        const int nig = WGM * nN, gid = wgid / nig, fm = gid * WGM, gsz = (nM - fm) < WGM ? (nM - fm) : WGM;
        u.pm = fm + ((wgid % nig) % gsz); u.pn = (wgid % nig) / gsz; return true;
    }
    __device__ __forceinline__ void a_ready(const Unit&) const {}
    __device__ __forceinline__ void done(const Unit&) const {}
};


__device__ __forceinline__ unsigned cvt_pk_bf16(float lo, float hi) { unsigned r; asm volatile("v_cvt_pk_bf16_f32 %0, %1, %2" : "=v"(r) : "v"(lo), "v"(hi)); return r; }
__device__ __forceinline__ float bf_lo(unsigned w) { return __uint_as_float(w << 16); }
__device__ __forceinline__ float bf_hi(unsigned w) { return __uint_as_float(w & 0xffff0000u); }
__device__ __forceinline__ float fsigmoid(float x) { return __builtin_amdgcn_rcpf(1.f + __expf(-x)); }
__device__ __forceinline__ float gelu_tanh(float x) { const float z2 = 1.5957691216f * (x + 0.044715f * x * x * x); return x * fsigmoid(z2); }
constexpr float RMS_EPS = 1e-6f;
__device__ __forceinline__ float row_rstd(const float* rowss, int row) { const f32x4* p = (const f32x4*)(rowss + (size_t)row * 16); const f32x4 a = p[0], b = p[1], c = p[2], d = p[3];
    const float s = ((a[0] + a[1]) + (a[2] + a[3])) + ((b[0] + b[1]) + (b[2] + b[3])) + ((c[0] + c[1]) + (c[2] + c[3])) + ((d[0] + d[1]) + (d[2] + d[3])); return __builtin_amdgcn_rsqf(s * (1.0f / 1024.0f) + RMS_EPS); }

struct EpiSwiglu {
    static constexpr bool PERM = true, AFTER_DRAIN = false;
    bf16_t* H; const float* rowss; int ldh;
    __device__ __forceinline__ void operator()(const f32x4 (&acc)[2][2][4][2], const Unit& u, int wr, int wc, int fr, int fq) const {
        const int row0 = u.pm * BM + wr * 64 + fr, col0 = u.pn * HALF + wc * 32 + 8 * fq;
#pragma unroll
        for (int ai = 0; ai < 2; ++ai)
#pragma unroll
            for (int m = 0; m < 4; ++m) { const int row = row0 + ai * HALF + m * 16; const float rs = row_rstd(rowss, row);
                float h[8];
#pragma unroll
                for (int n = 0; n < 2; ++n)
#pragma unroll
                    for (int e = 0; e < 4; ++e) { const float g = acc[ai][0][m][n][e] * rs, uu = acc[ai][1][m][n][e] * rs; h[4 * n + e] = g * fsigmoid(g) * uu; }
                u32x4 w; w.x = cvt_pk_bf16(h[0], h[1]); w.y = cvt_pk_bf16(h[2], h[3]); w.z = cvt_pk_bf16(h[4], h[5]); w.w = cvt_pk_bf16(h[6], h[7]);
                *(u32x4*)(H + (((size_t)u.pm * (ldh / 64) + (col0 >> 6)) * 256 + (row & 255)) * 64 + (col0 & 63)) = w; }
    }
};
struct EpiResid {
    static constexpr bool PERM = true, AFTER_DRAIN = false;
    bf16_t* xb; float* out; float* rowss; float scale;
    __device__ __forceinline__ void operator()(const f32x4 (&acc)[2][2][4][2], const Unit& u, int wr, int wc, int fr, int fq) const {
        const int row0 = u.pm * BM + wr * 64 + fr, col0 = u.pn * BM + wc * 32 + 8 * fq;
#pragma unroll
        for (int ai = 0; ai < 2; ++ai) {
            u32x4 bs[4][2];
#pragma unroll
            for (int m = 0; m < 4; ++m) { const size_t off = (size_t)(row0 + ai * HALF + m * 16) * 1024 + col0;
#pragma unroll
                for (int bj = 0; bj < 2; ++bj) bs[m][bj] = *(const u32x4*)(xb + off + bj * HALF); }
#pragma unroll
            for (int m = 0; m < 4; ++m) { const int row = row0 + ai * HALF + m * 16; const size_t off = (size_t)row * 1024 + col0; float s = 0.f;
#pragma unroll
                for (int bj = 0; bj < 2; ++bj) { const u32x4 b4 = bs[m][bj]; const f32x4 a0 = acc[ai][bj][m][0] * scale, a1 = acc[ai][bj][m][1] * scale;
                    float o[8];
                    o[0] = bf_lo(b4.x) + a0[0]; o[1] = bf_hi(b4.x) + a0[1]; o[2] = bf_lo(b4.y) + a0[2]; o[3] = bf_hi(b4.y) + a0[3];
                    o[4] = bf_lo(b4.z) + a1[0]; o[5] = bf_hi(b4.z) + a1[1]; o[6] = bf_lo(b4.w) + a1[2]; o[7] = bf_hi(b4.w) + a1[3];
                    s += ((o[0] * o[0] + o[1] * o[1]) + (o[2] * o[2] + o[3] * o[3])) + ((o[4] * o[4] + o[5] * o[5]) + (o[6] * o[6] + o[7] * o[7]));
                    if (out) { *(f32x4*)(out + off + bj * HALF) = (f32x4){o[0], o[1], o[2], o[3]}; *(f32x4*)(out + off + bj * HALF + 4) = (f32x4){o[4], o[5], o[6], o[7]}; }
                    else { u32x4 w; w.x = cvt_pk_bf16(o[0], o[1]); w.y = cvt_pk_bf16(o[2], o[3]); w.z = cvt_pk_bf16(o[4], o[5]); w.w = cvt_pk_bf16(o[6], o[7]); *(u32x4*)(xb + off + bj * HALF) = w; } }
                if (rowss) { s += __shfl_xor(s, 16); s += __shfl_xor(s, 32); if (fq == 0) rowss[(size_t)row * 16 + u.pn * 4 + wc] = s; } }
        }
    }
};
struct EpiIn {
    static constexpr bool PERM = true, AFTER_DRAIN = false;
    bf16_t *q, *k, *v, *xr, *yr, *gl; const float* rowss; const float* bgate;
    __device__ __forceinline__ void operator()(const f32x4 (&acc)[2][2][4][2], const Unit& u, int wr, int wc, int fr, int fq) const {
        const int pn = u.pn; bf16_t* base; int ldc, colt, mode = 0;
        if (pn < 4) { base = q; ldc = 1024; colt = 256 * pn; }
        else if (pn == 4) { base = k; ldc = 256; colt = 0; mode = 3; }
        else if (pn == 5) { base = v; ldc = 256; colt = 0; mode = 4; }
        else if (pn < 10) { base = xr; ldc = 1024; colt = 256 * (pn - 6); }
        else if (pn < 14) { base = yr; ldc = 1024; colt = 256 * (pn - 10); mode = 1; }
        else { base = gl; ldc = 2048; colt = 256 * (pn - 14); mode = 2; }
        const int row0 = u.pm * BM + wr * 64 + fr, col0 = colt + wc * 32 + 8 * fq;
        f32x4 bv[2][2];
#pragma unroll
        for (int bj = 0; bj < 2; ++bj)
#pragma unroll
            for (int n = 0; n < 2; ++n) bv[bj][n] = (mode == 2) ? *(const f32x4*)(bgate + col0 + bj * HALF + 4 * n) : (f32x4){0.f, 0.f, 0.f, 0.f};
#pragma unroll
        for (int ai = 0; ai < 2; ++ai)
#pragma unroll
            for (int m = 0; m < 4; ++m) { const int row = row0 + ai * HALF + m * 16; const float rs = row_rstd(rowss, row); bf16_t* rowp = base + (size_t)row * ldc + col0;
#pragma unroll
                for (int bj = 0; bj < 2; ++bj) { float h[8];
#pragma unroll
                    for (int n = 0; n < 2; ++n)
#pragma unroll
                        for (int e = 0; e < 4; ++e) h[4 * n + e] = acc[ai][bj][m][n][e] * rs;
                    if (mode == 1) { asm volatile("" ::: "memory");
#pragma unroll
                        for (int e = 0; e < 8; ++e) h[e] = gelu_tanh(h[e]); }
                    else if (mode == 2) { asm volatile("" ::: "memory");
#pragma unroll
                        for (int e = 0; e < 8; ++e) h[e] = fsigmoid(h[e] + bv[bj][e >> 2][e & 3]); }
                    u32x4 w; w.x = cvt_pk_bf16(h[0], h[1]); w.y = cvt_pk_bf16(h[2], h[3]); w.z = cvt_pk_bf16(h[4], h[5]); w.w = cvt_pk_bf16(h[6], h[7]);
                    if (mode >= 3) {
                        const int col = col0 + bj * HALF, kvh = col >> 6, d0 = col & 63, bb = row >> 13, sq = row & 8191, tt = sq >> 6, rr = sq & 63;
                        const size_t tb = ((size_t)(bb * 4 + kvh) * 128 + tt) * 4096;
                        *(u32x4*)(base + tb + (mode == 3 ? (size_t)((d0 >> 3) * 512 + rr * 8) : (size_t)((d0 >> 5) * 2048 + rr * 32 + (d0 & 31)))) = w;
                    } else if (mode == 2) {
                        const int blk = ((colt + wc * 32) >> 6) + 2 * bj; *(u32x4*)(base + (size_t)row * 2048 + (((blk ^ fr) << 6) + (wc & 1) * 32 + 8 * fq)) = w;
                    } else *(u32x4*)(rowp + bj * HALF) = w; } }
    }
};
template <bool ACCUM> struct EpiGate {
    static constexpr bool PERM = true, AFTER_DRAIN = false;
    bf16_t* O; const bf16_t* gl; int goff;
    __device__ __forceinline__ void operator()(const f32x4 (&acc)[2][2][4][2], const Unit& u, int wr, int wc, int fr, int fq) const {
        const int row0 = u.pm * BM + wr * 64 + fr, col0 = u.pn * BM + wc * 32 + 8 * fq;
#pragma unroll
        for (int ai = 0; ai < 2; ++ai)
#pragma unroll
            for (int m = 0; m < 4; ++m) { const int row = row0 + ai * HALF + m * 16;
#pragma unroll
                for (int bj = 0; bj < 2; ++bj) { const int col = col0 + bj * HALF;
                    const int gc = goff + col; const u32x4 g = *(const u32x4*)(gl + (size_t)row * 2048 + ((((gc >> 6) ^ (row & 15)) << 6) | (gc & 63))); bf16_t* op = O + (size_t)row * 1024 + col;
                    u32x4 pv = (u32x4){0u, 0u, 0u, 0u}; if (ACCUM) pv = *(const u32x4*)op;
                    const f32x4 a0 = acc[ai][bj][m][0], a1 = acc[ai][bj][m][1];
                    float h[8];
                    h[0] = bf_lo(g.x) * a0[0]; h[1] = bf_hi(g.x) * a0[1]; h[2] = bf_lo(g.y) * a0[2]; h[3] = bf_hi(g.y) * a0[3];
                    h[4] = bf_lo(g.z) * a1[0]; h[5] = bf_hi(g.z) * a1[1]; h[6] = bf_lo(g.w) * a1[2]; h[7] = bf_hi(g.w) * a1[3];
                    if (ACCUM) { h[0] += bf_lo(pv.x); h[1] += bf_hi(pv.x); h[2] += bf_lo(pv.y); h[3] += bf_hi(pv.y); h[4] += bf_lo(pv.z); h[5] += bf_hi(pv.z); h[6] += bf_lo(pv.w); h[7] += bf_hi(pv.w); }
                    u32x4 w; w.x = cvt_pk_bf16(h[0], h[1]); w.y = cvt_pk_bf16(h[2], h[3]); w.z = cvt_pk_bf16(h[4], h[5]); w.w = cvt_pk_bf16(h[6], h[7]);
                    *(u32x4*)op = w; } }
    }
};

template <class Epi, class Sched, bool ALIGN_EPI = false, bool SP2 = false, bool ATILED = false>
__device__ __forceinline__ void gemm_phase(PG8_LAS unsigned char* lds, const Gemm g, const Sched& S, const Epi& E) {
    const int tid = otid(), wid = __builtin_amdgcn_readfirstlane(tid >> 6), lane = tid & 63, wr = wid >> 2, wc = wid & 3, fr = lane & 15, fq = lane >> 4;
    const int K = g.K, nt = K / BK;
    unsigned voffA[2], voffB[2];
#pragma unroll
    for (int i = 0; i < 2; ++i) { int R, C; stage_rc(tid * 16 + i * 8192, R, C); const int Rb = Epi::PERM ? ((R & ~31) + perm32(R & 31)) : R;
        voffA[i] = ATILED ? (unsigned)(R * 64 + C) * 2u : (unsigned)(R * K + C) * 2u; voffB[i] = (unsigned)(Rb * K + C) * 2u; }
    const size_t kstep = (size_t)(BK * 2);
    const size_t hstep = (size_t)HALF * K * 2;
    const size_t tstep = 2 * hstep;
    const size_t kstepA = ATILED ? (size_t)32768 : kstep, hstepA = ATILED ? (size_t)16384 : hstep, tstepA = ATILED ? (size_t)(K / BK) * 32768 : tstep;
    const unsigned ldsw = (unsigned)wid * 1024u;
    const int aoff = lds_byte(wr * 64 + fr, fq * 8), boff = lds_byte(wc * 32 + fr, fq * 8);
#define PG8_SA(b, h) (((b) * 2 + (h)) * HTB)
#define PG8_SB(b, h) ((4 + (b) * 2 + (h)) * HTB)
#define PG8_STAGE(bufoff, gbase, voff) do { _Pragma("unroll") for (int _i = 0; _i < 2; ++_i) \
        __builtin_amdgcn_global_load_lds((const unsigned*)((const char*)(gbase) + (voff)[_i]), (PG8_LAS unsigned*)(lds + (bufoff) + ldsw + _i * 8192), 16, 0, 0); } while (0)
#define PG8_LDA(dst, b, h) do { _Pragma("unroll") for (int m = 0; m < 4; ++m) _Pragma("unroll") for (int k = 0; k < 2; ++k) dst[m][k] = *(const PG8_LAS bf16x8*)(lds + PG8_SA(b, h) + aoff + m * 2048 + k * 1024); } while (0)
#define PG8_LDB(dst, b, h) do { _Pragma("unroll") for (int n = 0; n < 2; ++n) _Pragma("unroll") for (int k = 0; k < 2; ++k) dst[n][k] = *(const PG8_LAS bf16x8*)(lds + PG8_SB(b, h) + boff + n * 2048 + k * 1024); } while (0)
#define PG8_MMA(ai, bj, At, Bt) do { __builtin_amdgcn_s_setprio(1); _Pragma("unroll") for (int m = 0; m < 4; ++m) _Pragma("unroll") for (int n = 0; n < 2; ++n) _Pragma("unroll") for (int k = 0; k < 2; ++k) \
        acc[ai][bj][m][n] = __builtin_amdgcn_mfma_f32_16x16x32_bf16(Bt[n][k], At[m][k], acc[ai][bj][m][n], 0, 0, 0); __builtin_amdgcn_s_setprio(0); } while (0)
#define PG8_WAIT_V(n) asm volatile("s_waitcnt vmcnt(" #n ")" ::: "memory")
#define PG8_WAIT_L(n) asm volatile("s_waitcnt lgkmcnt(" #n ")" ::: "memory")
#define PG8_BAR __builtin_amdgcn_s_barrier()
#define PG8_SCHED __builtin_amdgcn_sched_barrier(0)
    Unit cur, nxt; int ui = 0;
    if (!S.next(0, cur)) return;
    f32x4 acc[2][2][4][2];
#pragma unroll
    for (int a = 0; a < 2; ++a)
#pragma unroll
        for (int b = 0; b < 2; ++b)
#pragma unroll
            for (int m = 0; m < 4; ++m)
#pragma unroll
                for (int n = 0; n < 2; ++n) acc[a][b][m][n] = (f32x4){0.f, 0.f, 0.f, 0.f};
    bf16x8 At[4][2], B0[2][2], B1[2][2];
    const char* cA = (const char*)g.A + (size_t)cur.pm * tstepA; const char* cB = (const char*)g.Bt + (size_t)cur.pn * tstep;
    S.a_ready(cur);
    if constexpr (SP2) {
        PG8_STAGE(PG8_SB(0, 0), cB, voffB); PG8_STAGE(PG8_SB(0, 1), cB + hstep, voffB); PG8_STAGE(PG8_SA(0, 0), cA, voffA); PG8_STAGE(PG8_SA(0, 1), cA + hstepA, voffA);
        if (wr == 1) PG8_BAR;
        PG8_WAIT_V(2); PG8_BAR;
        PG8_STAGE(PG8_SB(1, 0), cB + kstep, voffB); PG8_STAGE(PG8_SA(1, 0), cA + kstepA, voffA); PG8_STAGE(PG8_SB(1, 1), cB + hstep + kstep, voffB);
        PG8_WAIT_V(6); PG8_BAR;
    } else {
        PG8_STAGE(PG8_SB(0, 0), cB, voffB); PG8_STAGE(PG8_SA(0, 0), cA, voffA); PG8_STAGE(PG8_SB(0, 1), cB + hstep, voffB); PG8_STAGE(PG8_SA(0, 1), cA + hstepA, voffA);
        if (wr == 1) PG8_BAR;
        PG8_WAIT_V(4); PG8_BAR;
        PG8_STAGE(PG8_SB(1, 0), cB + kstep, voffB); PG8_STAGE(PG8_SA(1, 0), cA + kstepA, voffA); PG8_STAGE(PG8_SB(1, 1), cB + hstep + kstep, voffB);
        PG8_WAIT_V(6); PG8_BAR;
    }
    for (;;) {
        const bool has_next = S.next(ui + 1, nxt);
        const char* nA = has_next ? (const char*)g.A + (size_t)nxt.pm * tstepA : cA; const char* nB = has_next ? (const char*)g.Bt + (size_t)nxt.pn * tstep : cB;
        for (int t = 0; t < nt; t += 2) {
            const bool last = (t == nt - 2);
            const char* a1 = cA + (size_t)(t + 1) * kstepA;
            const char* a2 = last ? nA : cA + (size_t)(t + 2) * kstepA; const char* b2 = last ? nB : cB + (size_t)(t + 2) * kstep;
            const char* a3 = a2 + kstepA; const char* b3 = b2 + kstep;
            if (last && has_next) S.a_ready(nxt);
            if constexpr (SP2) {
            PG8_LDB(B0, 0, 0); PG8_LDB(B1, 0, 1); PG8_SCHED; PG8_LDA(At, 0, 0); PG8_STAGE(PG8_SA(1, 1), a1 + hstepA, voffA);
            PG8_WAIT_V(8); PG8_WAIT_L(0); PG8_BAR; PG8_MMA(0, 0, At, B0); PG8_MMA(0, 1, At, B1); PG8_BAR; PG8_SCHED;
            PG8_LDA(At, 0, 1); PG8_STAGE(PG8_SB(0, 0), b2, voffB); PG8_STAGE(PG8_SB(0, 1), b2 + hstep, voffB); PG8_STAGE(PG8_SA(0, 0), a2, voffA);
            PG8_WAIT_V(8); PG8_WAIT_L(0); PG8_BAR; PG8_MMA(1, 0, At, B0); PG8_MMA(1, 1, At, B1); PG8_BAR; PG8_SCHED;
            PG8_LDB(B0, 1, 0); PG8_LDB(B1, 1, 1); PG8_SCHED; PG8_LDA(At, 1, 0); PG8_STAGE(PG8_SA(0, 1), a2 + hstepA, voffA);
            PG8_WAIT_V(8); PG8_WAIT_L(0); PG8_BAR; PG8_MMA(0, 0, At, B0); PG8_MMA(0, 1, At, B1); PG8_BAR; PG8_SCHED;
            PG8_LDA(At, 1, 1); PG8_STAGE(PG8_SB(1, 0), b3, voffB); PG8_STAGE(PG8_SB(1, 1), b3 + hstep, voffB); PG8_STAGE(PG8_SA(1, 0), a3, voffA);
            PG8_WAIT_V(8); PG8_WAIT_L(0); PG8_BAR; PG8_MMA(1, 0, At, B0); PG8_MMA(1, 1, At, B1); PG8_BAR; PG8_SCHED;
            } else {
            PG8_LDB(B0, 0, 0); PG8_SCHED; PG8_LDA(At, 0, 0); PG8_STAGE(PG8_SA(1, 1), a1 + hstepA, voffA);
            PG8_WAIT_L(8); PG8_BAR; PG8_WAIT_L(0); PG8_MMA(0, 0, At, B0); PG8_BAR; PG8_SCHED;
            PG8_LDB(B1, 0, 1); PG8_STAGE(PG8_SB(0, 0), b2, voffB);
            PG8_BAR; PG8_WAIT_L(0); PG8_MMA(0, 1, At, B1); PG8_BAR;
            PG8_LDA(At, 0, 1); PG8_STAGE(PG8_SA(0, 0), a2, voffA);
            PG8_BAR; PG8_WAIT_L(0); PG8_MMA(1, 0, At, B0); PG8_BAR; PG8_SCHED;
            PG8_STAGE(PG8_SB(0, 1), b2 + hstep, voffB);
            PG8_WAIT_V(6); PG8_BAR; PG8_MMA(1, 1, At, B1); PG8_BAR;
            PG8_LDB(B0, 1, 0); PG8_SCHED; PG8_LDA(At, 1, 0); PG8_STAGE(PG8_SA(0, 1), a2 + hstepA, voffA);
            PG8_WAIT_L(8); PG8_BAR; PG8_WAIT_L(0); PG8_MMA(0, 0, At, B0); PG8_BAR; PG8_SCHED;
            PG8_LDB(B1, 1, 1); PG8_STAGE(PG8_SB(1, 0), b3, voffB);
            PG8_BAR; PG8_WAIT_L(0); PG8_MMA(0, 1, At, B1); PG8_BAR;
            PG8_LDA(At, 1, 1); PG8_STAGE(PG8_SA(1, 0), a3, voffA);
            PG8_BAR; PG8_WAIT_L(0); PG8_MMA(1, 0, At, B0); PG8_BAR; PG8_SCHED;
            PG8_STAGE(PG8_SB(1, 1), b3 + hstep, voffB);
            PG8_WAIT_V(6); PG8_BAR; PG8_MMA(1, 1, At, B1); PG8_BAR;
            }
        }
        if constexpr (ALIGN_EPI) { if (wr == 0) PG8_BAR; }
        if constexpr (!Epi::AFTER_DRAIN) { E(acc, cur, wr, wc, fr, fq); S.done(cur); }
        if (!has_next) break;
#pragma unroll
        for (int a = 0; a < 2; ++a)
#pragma unroll
            for (int b = 0; b < 2; ++b)
#pragma unroll
                for (int m = 0; m < 4; ++m)
#pragma unroll
                    for (int n = 0; n < 2; ++n) acc[a][b][m][n] = (f32x4){0.f, 0.f, 0.f, 0.f};
        cur = nxt; cA = nA; cB = nB; ++ui;
        if constexpr (ALIGN_EPI) { if (wr == 1) PG8_BAR; }
    }
    PG8_WAIT_V(0);
    if constexpr (!ALIGN_EPI) { if (wr == 0) PG8_BAR; }
    PG8_BAR;
    if constexpr (Epi::AFTER_DRAIN) { E.fused(acc, cur, wr, wc, fr, fq, lds, wid, lane); S.done(cur); }
#undef PG8_SA
#undef PG8_SB
#undef PG8_STAGE
#undef PG8_LDA
#undef PG8_LDB
#undef PG8_MMA
#undef PG8_WAIT_V
#undef PG8_WAIT_L
#undef PG8_BAR
#undef PG8_SCHED
}
}

#include <hip/hip_bf16.h>
#include <cmath>
namespace attn_body {
using bf16=__hip_bfloat16;
using bf16x8=__attribute__((ext_vector_type(8)))short;
using s16x4=__attribute__((ext_vector_type(4)))short;
using f32x16=__attribute__((ext_vector_type(16)))float;
using u32x4=__attribute__((ext_vector_type(4)))unsigned;
constexpr int BATCH=4,NHEAD=16,NKV=4,GRP=NHEAD/NKV,SEQ=8192,D=64,DM=NHEAD*D,KVP=NKV*D;
constexpr int NW=8,QBLK=32,QB=QBLK*NW,KVBLK=64,NQB=SEQ/QB;
constexpr int ATTN_PITCH=DM, ATTN_UNIT_ROWS=QB;
__device__ __forceinline__ int crow(int r,int hi){return (r&3)+8*(r>>2)+4*hi;}
#define SBAR() __builtin_amdgcn_sched_barrier(0)
constexpr int NSLOT=3, SLOTB=8192;
constexpr int LDS_K=0, LDS_V=NSLOT*SLOTB, LDS_WS=2*NSLOT*SLOTB, LDS_OST=LDS_WS+NW*64*4, LDS_BYTES=LDS_OST+NW*4096;
constexpr float C2=0.125f*1.4426950408889634f;
__device__ __forceinline__ void glds16(const void*gsrc,unsigned lds_dst){unsigned keep;
  asm volatile("s_mov_b32 %0, m0\n\ts_mov_b32 m0, %2\n\ts_nop 0\n\tglobal_load_lds_dwordx4 %1, off\n\ts_mov_b32 m0, %0":"=&s"(keep):"v"(gsrc),"s"(lds_dst):"memory");}
__device__ __forceinline__ float max3f(float a,float b,float c){float r;asm("v_max3_f32 %0, %1, %2, %3":"=v"(r):"v"(a),"v"(b),"v"(c));return r;}
__device__ __forceinline__ float max2f(float a,float b){float r;asm("v_max_f32_e32 %0, %1, %2":"=v"(r):"v"(a),"v"(b));return r;}
__device__ __forceinline__ float fadd_s(float a,float b){float r;asm("v_add_f32_e32 %0, %1, %2":"=v"(r):"v"(a),"v"(b));return r;}
__device__ __forceinline__ float fsub_s(float a,float b){float r;asm("v_sub_f32_e32 %0, %1, %2":"=v"(r):"v"(a),"v"(b));return r;}
typedef float f32x2_t __attribute__((ext_vector_type(2))); typedef __bf16 bf16x2_t __attribute__((ext_vector_type(2)));
__device__ __forceinline__ unsigned cvtpk_s(float lo,float hi){f32x2_t v={lo,hi};bf16x2_t b=__builtin_convertvector(v,bf16x2_t);return __builtin_bit_cast(unsigned,b);}
#define WAIT_BAR(N) asm volatile("s_waitcnt vmcnt(" #N ") lgkmcnt(0)\n\ts_barrier":::"memory")

__device__ __forceinline__ void qkt(f32x16&p0,f32x16&p1,const char*Kslot,const bf16x8*qr,const f32x16&negm,int r32,int hi){
  const char*kb=Kslot+hi*1024+r32*16;
  #pragma unroll
  for(int d0=0;d0<4;++d0){
    const bf16x8 b0=*reinterpret_cast<const bf16x8*>(kb+d0*2048);
    const bf16x8 b1=*reinterpret_cast<const bf16x8*>(kb+d0*2048+512);
    if(d0==0){p0=__builtin_amdgcn_mfma_f32_32x32x16_bf16(b0,qr[0],negm,0,0,0);p1=__builtin_amdgcn_mfma_f32_32x32x16_bf16(b1,qr[0],negm,0,0,0);}
    else{p0=__builtin_amdgcn_mfma_f32_32x32x16_bf16(b0,qr[d0],p0,0,0,0);p1=__builtin_amdgcn_mfma_f32_32x32x16_bf16(b1,qr[d0],p1,0,0,0);}}
}
typedef __attribute__((address_space(3))) const char* lds_cptr;
typedef short v4i16_t __attribute__((ext_vector_type(4)));
__device__ __forceinline__ void kload8(bf16x8*kf,lds_cptr kp){
  kf[0]=*(const __attribute__((address_space(3))) bf16x8*)(kp);      kf[1]=*(const __attribute__((address_space(3))) bf16x8*)(kp+512);
  kf[2]=*(const __attribute__((address_space(3))) bf16x8*)(kp+2048); kf[3]=*(const __attribute__((address_space(3))) bf16x8*)(kp+2560);
  kf[4]=*(const __attribute__((address_space(3))) bf16x8*)(kp+4096); kf[5]=*(const __attribute__((address_space(3))) bf16x8*)(kp+4608);
  kf[6]=*(const __attribute__((address_space(3))) bf16x8*)(kp+6144); kf[7]=*(const __attribute__((address_space(3))) bf16x8*)(kp+6656);
}
__device__ __forceinline__ void kload2(bf16x8*kf,lds_cptr kp,int j){ kf[2*j]=*(const __attribute__((address_space(3))) bf16x8*)(kp+j*2048); kf[2*j+1]=*(const __attribute__((address_space(3))) bf16x8*)(kp+j*2048+512); }
__device__ __forceinline__ s16x4 vtr(lds_cptr p){ return __builtin_bit_cast(s16x4,__builtin_amdgcn_ds_read_tr16_b64_v4i16((__attribute__((address_space(3))) v4i16_t*)p)); }
__device__ __forceinline__ float rowmax(const f32x16&p0,const f32x16&p1){
  float a=max3f(p0[0],p0[1],p1[0]),b=max3f(p0[2],p0[3],p1[1]);a=max3f(a,p1[2],p1[3]);
  #pragma unroll
  for(int r=4;r<16;r+=4){a=max3f(a,p0[r],p0[r+1]);b=max3f(b,p0[r+2],p0[r+3]);a=max3f(a,p1[r],p1[r+1]);b=max3f(b,p1[r+2],p1[r+3]);}
  const float m=max2f(a,b);
  auto rr=__builtin_amdgcn_permlane32_swap(__float_as_uint(m),__float_as_uint(m),false,false);
  return max2f(__uint_as_float(rr[0]),__uint_as_float(rr[1]));
}
__device__ __forceinline__ void pv(f32x16*o,int vb,bf16x8 pa0,bf16x8 pa1,bf16x8 pa2,bf16x8 pa3){
  #pragma unroll
  for(int d0=0;d0<2;++d0){s16x4 lo[4],hi[4];
    #pragma unroll
    for(int ks=0;ks<4;++ks){
      asm volatile("ds_read_b64_tr_b16 %0,%1 offset:%c2":"=&v"(lo[ks]):"v"(vb),"i"(d0*4096+ks*1024):"memory");
      asm volatile("ds_read_b64_tr_b16 %0,%1 offset:%c2":"=&v"(hi[ks]):"v"(vb),"i"(d0*4096+ks*1024+512):"memory");}
    asm volatile("s_waitcnt lgkmcnt(0)":::"memory");SBAR();
    #define PK(k) (bf16x8){lo[k][0],lo[k][1],lo[k][2],lo[k][3],hi[k][0],hi[k][1],hi[k][2],hi[k][3]}
    o[d0]=__builtin_amdgcn_mfma_f32_32x32x16_bf16(pa0,PK(0),o[d0],0,0,0);
    o[d0]=__builtin_amdgcn_mfma_f32_32x32x16_bf16(pa1,PK(1),o[d0],0,0,0);
    o[d0]=__builtin_amdgcn_mfma_f32_32x32x16_bf16(pa2,PK(2),o[d0],0,0,0);
    o[d0]=__builtin_amdgcn_mfma_f32_32x32x16_bf16(pa3,PK(3),o[d0],0,0,0);
    #undef PK
  }
}

#ifndef ATTN_STORE16
#define ATTN_STORE16(p,v) (*(u32x4*)(p)=(v))
#endif
template<int THRL,bool NOMAX> __device__ __forceinline__ void attn_unit(int b,int h,int qb,const bf16*Q,const bf16*__restrict__ K,const bf16*__restrict__ V,bf16*O,char*shm,const float*qgain){
  const int tid=otid(),lane=tid&63,r32=lane&31,hi=lane>>5; const int wid=__builtin_amdgcn_readfirstlane(tid>>6);
  const long rowbase=(long)b*SEQ; const int q0=qb*QB;
  const bf16*Qw=Q+(rowbase+q0+wid*QBLK)*DM+h*D;
  const bf16*Kh=K+(long)(b*NKV+h/GRP)*((long)SEQ*D),*Vh=V+(long)(b*NKV+h/GRP)*((long)SEQ*D);
  const unsigned lds0=(unsigned)(uintptr_t)shm;
  float*wsf=(float*)(shm+LDS_WS)+wid*64;
  const bf16*ksrc=Kh+wid*512+lane*8;
  const bf16*vsrc=Vh+wid*512+lane*8;
  const unsigned kdst=lds0+LDS_K+wid*1024, vdst=lds0+LDS_V+wid*1024;
  #define DMA_K(t,slot) glds16(ksrc+(long)(t)*(KVBLK*D),(unsigned)__builtin_amdgcn_readfirstlane(kdst+(slot)))
  #define DMA_V(t,slot) glds16(vsrc+(long)(t)*(KVBLK*D),(unsigned)__builtin_amdgcn_readfirstlane(vdst+(slot)))
  const int vb0=(int)(lds0+LDS_V)+((lane>>4)&1)*32+(lane&3)*8+(4*hi+((lane&15)>>2))*64;
  const char*Kbase=shm+LDS_K; bf16x8 kf[8];
  const lds_cptr shm3=(lds_cptr)shm; const lds_cptr kp0=shm3+LDS_K+hi*1024+r32*16; const lds_cptr vp0=shm3+LDS_V+((lane>>4)&1)*32+(lane&3)*8+(4*hi+((lane&15)>>2))*64;
  const int NT=SEQ/KVBLK;
  DMA_K(0,0);DMA_V(0,0);DMA_K(1,SLOTB);
  bf16x8 qr[4];
  #pragma unroll
  for(int d0=0;d0<4;++d0)qr[d0]=*reinterpret_cast<const bf16x8*>(&Qw[(long)r32*DM+d0*16+hi*8]);
  {
    float xq[4][8]; float ss=0.f;
    #pragma unroll
    for(int d0=0;d0<4;++d0){
      #pragma unroll
      for(int e=0;e<8;++e){ xq[d0][e]=__uint_as_float(((unsigned)(unsigned short)qr[d0][e])<<16); ss+=xq[d0][e]*xq[d0][e]; } }
    ss+=__shfl_xor(ss,32);
    const float rs=__builtin_amdgcn_rsqf(ss*(1.0f/64.0f)+1e-6f);
    const int sq=q0+wid*QBLK+r32; const float prow=(float)(sq>>6), pcol=(float)(sq&63);
    #pragma unroll
    for(int e=0;e<8;++e){ const int ii=8*hi+e; const float inv=exp2f(-(float)ii*0.83048202372184f);
      const float ar=prow*inv, ac=pcol*inv, cr=__cosf(ar), sr=__sinf(ar), cc=__cosf(ac), sc=__sinf(ac);
      const float a=xq[0][e]*rs*qgain[ii], bq=xq[1][e]*rs*qgain[16+ii], a2=xq[2][e]*rs*qgain[32+ii], b2=xq[3][e]*rs*qgain[48+ii];
      const float o0=(a*cr-bq*sr)*C2, o1=(bq*cr+a*sr)*C2, o2=(a2*cc-b2*sc)*C2, o3=(b2*cc+a2*sc)*C2;
      const bf16 h0=__float2bfloat16(o0), h1=__float2bfloat16(o1), h2=__float2bfloat16(o2), h3=__float2bfloat16(o3);
      qr[0][e]=(short)__builtin_bit_cast(unsigned short,h0); qr[1][e]=(short)__builtin_bit_cast(unsigned short,h1); qr[2][e]=(short)__builtin_bit_cast(unsigned short,h2); qr[3][e]=(short)__builtin_bit_cast(unsigned short,h3); }
  }
  float mhat=0.f,l_reg=0.f;f32x16 o[2];o[0]=f32x16{};o[1]=f32x16{};f32x16 negm=f32x16{};asm volatile("":"+v"(negm));
    #define CMASK(P0,P1,t) do{}while(0)
  bool resc=false;
  #define START(P0,P1) do{ resc=false; if constexpr(!NOMAX){ const float rm=rowmax(P0,P1); \
    { const float dl=rm; mhat=fadd_s(mhat,dl); \
      _Pragma("unroll") for(int r=0;r<16;++r){P0[r]=fsub_s(P0[r],dl);P1[r]=fsub_s(P1[r],dl);} \
      _Pragma("unroll") for(int r=0;r<16;++r)negm[r]=-mhat; asm volatile("":"+v"(negm)); } } \
    _Pragma("unroll") for(int r=0;r<16;++r)P0[r]=__builtin_amdgcn_exp2f(P0[r]); }while(0)
  #define RESC() do{ if(resc){ asm volatile("s_waitcnt lgkmcnt(0)":::"memory"); \
      _Pragma("unroll") for(int d_=0;d_<2;++d_) _Pragma("unroll") for(int r=0;r<16;++r)o[d_][r]*=wsf[crow(r,hi)]; } }while(0)
  f32x16 pA0,pA1,pB0,pB1;
  int sl_prev=0,sl_cur=0,sl_next=SLOTB;
  #define ROT() do{sl_prev=sl_cur;sl_cur=sl_next;sl_next=(sl_next==(NSLOT-1)*SLOTB)?0:sl_next+SLOTB;}while(0)
  DMA_K(2,2*SLOTB);
  WAIT_BAR(3);
  qkt(pA0,pA1,Kbase,qr,negm,r32,hi);asm volatile("s_nop 15\n\ts_nop 7":"+v"(pA0),"+v"(pA1));CMASK(pA0,pA1,0);
  START(pA0,pA1);
  _Pragma("unroll") for(int r=0;r<16;++r)pA1[r]=__builtin_amdgcn_exp2f(pA1[r]);
  WAIT_BAR(0);
  DMA_K(3,0);DMA_V(1,SLOTB);
  ROT();
  kload8(kf,kp0+sl_cur);
  WAIT_BAR(2);
  s16x4 vlo[8],vhi[8]; u32x4 pw0,pw1,pw2,pw3;
  #define PKW(P,B) cvtpk_s(P[B],P[B+1])
  #define PAF(k) __builtin_bit_cast(bf16x8,pw##k)
  #define VFR(i) (bf16x8){vlo[i][0],vlo[i][1],vlo[i][2],vlo[i][3],vhi[i][0],vhi[i][1],vhi[i][2],vhi[i][3]}
  #define PIN(x) asm volatile("":"+v"(x))
  #define MX3(a,b,c) __builtin_fmaxf(__builtin_fmaxf((a),(b)),(c))
  #define GAPA(MF,A0,A1,A2,A3,W0,W1,PW) do{ MF; sacc+=A0; sacc+=A1; sacc+=A2; sacc+=A3; PIN(sacc); W0; W1; PIN(PW); SBAR(); }while(0)
  #define EX(v) __builtin_amdgcn_exp2f(v)
  #define GAPB(MF,X,B) do{ MF; X[B]=EX(X[B]); X[B+1]=EX(X[B+1]); X[B+2]=EX(X[B+2]); X[B+3]=EX(X[B+3]); PIN(X); SBAR(); }while(0)
  #define VRD(i) do{ vlo[i]=vtr(vp_+(((i)>>2)*4096+((i)&3)*1024)); vhi[i]=vtr(vp_+(((i)>>2)*4096+((i)&3)*1024+512)); }while(0)
  #define KRD(G,j) do{ if(G){ kload2(kf,kp0+sl_next,j); SBAR(); } }while(0)
  #define STEP(C0,C1,P0,P1,t,GK,GV,GL) do{ SBAR(); \
    const lds_cptr vp_=vp0+sl_prev; \
    VRD(0); SBAR(); float sacc=(P0[0]+P0[1]); \
    GAPA(C0=__builtin_amdgcn_mfma_f32_32x32x16_bf16(kf[0],qr[0],negm,0,0,0), P0[2],P0[3],P0[4],P0[5],     pw0[0]=PKW(P0,0), pw0[1]=PKW(P0,2), pw0); \
    VRD(4); SBAR(); GAPA(C1=__builtin_amdgcn_mfma_f32_32x32x16_bf16(kf[1],qr[0],negm,0,0,0), P0[6],P0[7],P0[8],P0[9],     pw0[2]=PKW(P0,4), pw0[3]=PKW(P0,6), pw0); \
    VRD(1); SBAR(); GAPA(C0=__builtin_amdgcn_mfma_f32_32x32x16_bf16(kf[2],qr[1],C0,0,0,0),   P0[10],P0[11],P0[12],P0[13], pw1[0]=PKW(P0,8), pw1[1]=PKW(P0,10), pw1); \
    VRD(5); SBAR(); GAPA(C1=__builtin_amdgcn_mfma_f32_32x32x16_bf16(kf[3],qr[1],C1,0,0,0),   P0[14],P0[15],P1[0],P1[1],   pw1[2]=PKW(P0,12),pw1[3]=PKW(P0,14), pw1); \
    VRD(2); SBAR(); GAPA(C0=__builtin_amdgcn_mfma_f32_32x32x16_bf16(kf[4],qr[2],C0,0,0,0),   P1[2],P1[3],P1[4],P1[5],     pw2[0]=PKW(P1,0), pw2[1]=PKW(P1,2), pw2); \
    VRD(6); SBAR(); GAPA(C1=__builtin_amdgcn_mfma_f32_32x32x16_bf16(kf[5],qr[2],C1,0,0,0),   P1[6],P1[7],P1[8],P1[9],     pw2[2]=PKW(P1,4), pw2[3]=PKW(P1,6), pw2); \
    VRD(3); SBAR(); GAPA(C0=__builtin_amdgcn_mfma_f32_32x32x16_bf16(kf[6],qr[3],C0,0,0,0),   P1[10],P1[11],P1[12],P1[13], pw3[0]=PKW(P1,8), pw3[1]=PKW(P1,10), pw3); \
    VRD(7); SBAR(); GAPA(C1=__builtin_amdgcn_mfma_f32_32x32x16_bf16(kf[7],qr[3],C1,0,0,0),   P1[14],P1[15],0.f,0.f,       pw3[2]=PKW(P1,12),pw3[3]=PKW(P1,14), pw3); \
    l_reg+=sacc; \
    if(GK){DMA_K((t)+3,sl_cur);} if(GV){DMA_V((t)+1,sl_next);} \
    CMASK(C0,C1,t); \
    resc=false; if constexpr(!NOMAX){ float a=MX3(C0[0],C0[1],C1[0]),b=MX3(C0[2],C0[3],C1[1]); a=MX3(a,C1[2],C1[3]); \
      _Pragma("unroll") for(int r=4;r<16;r+=4){a=MX3(a,C0[r],C0[r+1]);b=MX3(b,C0[r+2],C0[r+3]);a=MX3(a,C1[r],C1[r+1]);b=MX3(b,C1[r+2],C1[r+3]);} \
      float rm=__builtin_fmaxf(a,b); { auto rr=__builtin_amdgcn_permlane32_swap(__float_as_uint(rm),__float_as_uint(rm),false,false); rm=__builtin_fmaxf(__uint_as_float(rr[0]),__uint_as_float(rr[1])); } \
      resc=false; \
      if(__builtin_expect(__any(rm>(float)THRL),0)){ const float dl=__builtin_fmaxf(rm,0.f); mhat+=dl; \
        _Pragma("unroll") for(int r=0;r<16;++r){C0[r]-=dl;C1[r]-=dl;} \
        _Pragma("unroll") for(int r=0;r<16;++r)negm[r]=-mhat; asm volatile("":"+v"(negm)); \
        const float f=__builtin_amdgcn_exp2f(-dl); l_reg*=f; if(hi==0)wsf[r32]=f; resc=true; } } \
    SBAR(); \
    GAPB(o[0]=__builtin_amdgcn_mfma_f32_32x32x16_bf16(PAF(0),VFR(0),o[0],0,0,0), C0,0); \
    GAPB(o[1]=__builtin_amdgcn_mfma_f32_32x32x16_bf16(PAF(0),VFR(4),o[1],0,0,0), C0,4); \
    KRD(GL,0); GAPB(o[0]=__builtin_amdgcn_mfma_f32_32x32x16_bf16(PAF(1),VFR(1),o[0],0,0,0), C0,8); \
    KRD(GL,1); GAPB(o[1]=__builtin_amdgcn_mfma_f32_32x32x16_bf16(PAF(1),VFR(5),o[1],0,0,0), C0,12); \
    KRD(GL,2); GAPB(o[0]=__builtin_amdgcn_mfma_f32_32x32x16_bf16(PAF(2),VFR(2),o[0],0,0,0), C1,0); \
    KRD(GL,3); GAPB(o[1]=__builtin_amdgcn_mfma_f32_32x32x16_bf16(PAF(2),VFR(6),o[1],0,0,0), C1,4); \
    GAPB(o[0]=__builtin_amdgcn_mfma_f32_32x32x16_bf16(PAF(3),VFR(3),o[0],0,0,0), C1,8); \
    GAPB(o[1]=__builtin_amdgcn_mfma_f32_32x32x16_bf16(PAF(3),VFR(7),o[1],0,0,0), C1,12); \
    }while(0)
  int t=1;
  #undef CMASK
  #define CMASK(P0,P1,t) do{}while(0)
  for(;t+5<NT;t+=2){
    STEP(pB0,pB1,pA0,pA1,t,true,true,true);     WAIT_BAR(2); RESC(); ROT();
    STEP(pA0,pA1,pB0,pB1,t+1,true,true,true);   WAIT_BAR(2); RESC(); ROT();
  }
  #undef CMASK
  #define CMASK(P0,P1,t) do{}while(0)
  #define ENDW(tt) do{ if((tt)+3<NT){WAIT_BAR(2);} else if((tt)+2<NT){WAIT_BAR(1);} else {WAIT_BAR(0);} }while(0)
  for(;t+1<NT;t+=2){
    STEP(pB0,pB1,pA0,pA1,t,(t+3<NT),(t+1<NT),(t+1<NT));       ENDW(t);   RESC(); ROT();
    STEP(pA0,pA1,pB0,pB1,t+1,(t+4<NT),(t+2<NT),(t+2<NT));     ENDW(t+1); RESC(); ROT();
  }
  STEP(pB0,pB1,pA0,pA1,NT-1,false,false,false); RESC();
  { float sacc=pB0[0]+pB0[1]; _Pragma("unroll") for(int r=2;r<16;++r)sacc+=pB0[r]; _Pragma("unroll") for(int r=0;r<16;++r)sacc+=pB1[r]; l_reg+=sacc;
    pw0=(u32x4){PKW(pB0,0),PKW(pB0,2),PKW(pB0,4),PKW(pB0,6)};pw1=(u32x4){PKW(pB0,8),PKW(pB0,10),PKW(pB0,12),PKW(pB0,14)};pw2=(u32x4){PKW(pB1,0),PKW(pB1,2),PKW(pB1,4),PKW(pB1,6)};pw3=(u32x4){PKW(pB1,8),PKW(pB1,10),PKW(pB1,12),PKW(pB1,14)};
    SBAR(); pv(o,vb0+sl_cur,PAF(0),PAF(1),PAF(2),PAF(3)); }
  #undef PKW
  #undef PAF
  #undef VFR
  #undef PIN
  #undef MX3
  #undef GAPA
  #undef GAPB
  #undef EX
  #undef VRD
  #undef KRD
  #undef STEP
  #undef ENDW
  {auto rr=__builtin_amdgcn_permlane32_swap(__float_as_uint(l_reg),__float_as_uint(l_reg),false,false);l_reg=__uint_as_float(rr[0])+__uint_as_float(rr[1]);}
  if(hi==0)wsf[32+r32]=l_reg;asm volatile("s_waitcnt lgkmcnt(0)":::"memory");
  float rli[16];
  #pragma unroll
  for(int r=0;r<16;++r)rli[r]=__builtin_amdgcn_rcpf(wsf[32+crow(r,hi)]);
  bf16*Ow=O+(rowbase+q0+wid*QBLK)*DM+h*D;
  { bf16*stg=(bf16*)(shm+LDS_OST)+wid*2048;
    #pragma unroll
    for(int r=0;r<16;++r){const int orow=crow(r,hi);
      #pragma unroll
      for(int d0=0;d0<2;++d0)stg[orow*64+d0*32+r32]=__float2bfloat16(o[d0][r]*rli[r]);}
    asm volatile("s_waitcnt lgkmcnt(0)":::"memory");
    #pragma unroll
    for(int i=0;i<4;++i){const int row=i*8+(lane>>3),ch=lane&7; const u32x4 v=*(const u32x4*)(stg+row*64+ch*8); ATTN_STORE16(Ow+(long)row*DM+ch*8,v);} }
  asm volatile("s_waitcnt lgkmcnt(0)\n\ts_barrier":::"memory");
  #undef DMA_K
  #undef DMA_V
  #undef CMASK
  #undef START
  #undef RESC
  #undef ROT
}
constexpr int ATTN_LDS_BYTES=LDS_BYTES;
struct AttnTensors { const bf16* Q; const bf16* K; const bf16* V; bf16* O; };
struct AttnUnit { int bh; int qb; };
#undef SBAR
#undef WAIT_BAR
}

#include <hip/hip_cooperative_groups.h>
namespace cg = cooperative_groups;
#define LAS __attribute__((address_space(3)))
typedef unsigned short bf16;
typedef unsigned v4u __attribute__((ext_vector_type(4)));
typedef float f32x4 __attribute__((ext_vector_type(4)));
typedef short bf16x8 __attribute__((ext_vector_type(8)));
constexpr int NWAVES = 8, NTHREADS = 512;
constexpr int BATCH = 4, SEQ = 8192, DM = 1024, M = BATCH * SEQ, DFF = 2816, NIN = 5632, NLAYER = 2;
constexpr size_t MiB = 1u << 20;
constexpr size_t WS_ROWSS = 496 * MiB, WS_CIN = 0, WS_P = 2 * MiB, WS_E = 4 * MiB;
constexpr size_t WS_W1A = 6 * MiB, WS_W2A = 17 * MiB, WS_WIN = 22 * MiB + MiB / 2;
constexpr size_t WS_G2 = 34 * MiB, G2_STRIDE = 23 * MiB, G2_WAO = 0, G2_WRO = 2 * MiB, G2_WOUT = 4 * MiB, G2_W1B = 6 * MiB, G2_W2B = 17 * MiB;
constexpr size_t WS_XB = 80 * MiB, WS_Q = 144 * MiB, WS_K = 208 * MiB, WS_V = 224 * MiB, WS_XR = 240 * MiB, WS_YR = 304 * MiB, WS_GL = 368 * MiB, WS_BAR = 508 * MiB, WS_BAR_BYTES = 16384, WS_END = 508 * MiB + 65536;
constexpr size_t WS_HID = 144 * MiB;
constexpr int LDS_BYTES = 147456;
constexpr float RMS_EPS = 1e-6f;

__device__ __forceinline__ unsigned f2bf(float f) { unsigned u = __builtin_bit_cast(unsigned, f); return (u + 0x7fffu + ((u >> 16) & 1u)) >> 16; }
__device__ __forceinline__ unsigned pk2(float lo, float hi) { return f2bf(lo) | (f2bf(hi) << 16); }
__device__ __forceinline__ float bf2f(unsigned short v) { return __uint_as_float((unsigned)v << 16); }
__device__ __forceinline__ float wave_sum(float v) {
#pragma unroll
    for (int o = 1; o < 64; o <<= 1) v += __shfl_xor(v, o);
    return v;
}
__device__ __forceinline__ void transpose_item(const float* W, int K, int N, bf16* WT, const float* gain, bool w1perm, LAS float* scr, int item, int lane) {
    const int nblk = N / 32, kb = item / nblk, nb = item % nblk, k0 = 64 * kb, n0d = 32 * nb;
    const int n0s = w1perm ? (((n0d & 255) >> 7) * DFF + 128 * (n0d >> 8) + (n0d & 127)) : n0d;
#pragma unroll 8
    for (int i = 0; i < 32; ++i) { const int kk = 2 * i + (lane >> 5); float v = W[(size_t)(k0 + kk) * N + n0s + (lane & 31)]; if (gain) v *= gain[k0 + kk]; scr[kk * 33 + (lane & 31)] = v; }
    asm volatile("s_waitcnt lgkmcnt(0)" ::: "memory");
    const int c = lane & 7;
#pragma unroll
    for (int j = 0; j < 4; ++j) { const int n = (lane >> 3) + 8 * j; const LAS float* s = scr + (8 * c) * 33 + n;
        v4u o; o.x = pk2(s[0 * 33], s[1 * 33]); o.y = pk2(s[2 * 33], s[3 * 33]); o.z = pk2(s[4 * 33], s[5 * 33]); o.w = pk2(s[6 * 33], s[7 * 33]);
        *(v4u*)(WT + (size_t)(n0d + n) * K + k0 + 8 * c) = o; }
    asm volatile("s_waitcnt lgkmcnt(0)" ::: "memory");
}
__device__ __forceinline__ void convert_matrix(const float* W, int K, int N, bf16* WT, const float* gain, bool w1perm, LAS float* scr, int gw, int ngw, int lane) {
    const int nitems = (K / 64) * (N / 32);
    for (int it = gw; it < nitems; it += ngw) transpose_item(W, K, N, WT, gain, w1perm, scr, it, lane);
}
struct Params { const float* in[22]; float* out; unsigned char* ws; };
enum { I_X = 0, I_F1N, I_F1W1, I_F1W2, I_MIXN, I_WIN, I_BGATE, I_QN, I_KN, I_WAO, I_CONVW, I_CONVB, I_WA, I_BA, I_WX, I_BX, I_LAM, I_WRO, I_WOUT, I_F2N, I_F2W1, I_F2W2 };

__device__ __forceinline__ void convert_group1(const Params& p, int l, LAS float* scr, int gw, int ngw, int lane) {
    convert_matrix(p.in[I_F1W1] + (size_t)l * DM * NIN, DM, NIN, (bf16*)(p.ws + WS_W1A), p.in[I_F1N] + l * DM, true, scr, gw, ngw, lane);
    convert_matrix(p.in[I_F1W2] + (size_t)l * DFF * DM, DFF, DM, (bf16*)(p.ws + WS_W2A), nullptr, false, scr, gw, ngw, lane);
    convert_matrix(p.in[I_WIN] + (size_t)l * DM * NIN, DM, NIN, (bf16*)(p.ws + WS_WIN), p.in[I_MIXN] + l * DM, false, scr, gw, ngw, lane);
}
__device__ __forceinline__ void convert_group2(const Params& p, int l, LAS float* scr, int gw, int ngw, int lane) {
    unsigned char* g2 = p.ws + WS_G2 + (size_t)l * G2_STRIDE;
    convert_matrix(p.in[I_WAO] + (size_t)l * DM * DM, DM, DM, (bf16*)(g2 + G2_WAO), nullptr, false, scr, gw, ngw, lane);
    convert_matrix(p.in[I_WRO] + (size_t)l * DM * DM, DM, DM, (bf16*)(g2 + G2_WRO), nullptr, false, scr, gw, ngw, lane);
    convert_matrix(p.in[I_WOUT] + (size_t)l * DM * DM, DM, DM, (bf16*)(g2 + G2_WOUT), nullptr, false, scr, gw, ngw, lane);
    convert_matrix(p.in[I_F2W1] + (size_t)l * DM * NIN, DM, NIN, (bf16*)(g2 + G2_W1B), p.in[I_F2N] + l * DM, true, scr, gw, ngw, lane);
    convert_matrix(p.in[I_F2W2] + (size_t)l * DFF * DM, DFF, DM, (bf16*)(g2 + G2_W2B), nullptr, false, scr, gw, ngw, lane);
}
__device__ __forceinline__ void x_rows(const float* x, bf16* xb, float* rowss, int gw, int ngw, int lane) {
    for (int m = gw; m < M; m += ngw) {
        const f32x4* xr = (const f32x4*)(x + (size_t)m * DM) + lane; f32x4 v[4]; float s = 0.f;
#pragma unroll
        for (int j = 0; j < 4; ++j) { v[j] = xr[64 * j]; s += (v[j].x * v[j].x + v[j].y * v[j].y) + (v[j].z * v[j].z + v[j].w * v[j].w); }
        s = wave_sum(s);
        unsigned long long* o8 = (unsigned long long*)(xb + (size_t)m * DM) + lane;
#pragma unroll
        for (int j = 0; j < 4; ++j) o8[64 * j] = (unsigned long long)pk2(v[j].x, v[j].y) | ((unsigned long long)pk2(v[j].z, v[j].w) << 32);
        if (lane < 16) rowss[(size_t)m * 16 + lane] = (lane == 0) ? s : 0.f;
    }
}
__device__ __forceinline__ void qk_rope(bf16* q, bf16* k, const float* qn, const float* kn, int gtid, int nthreads) {
    const int total = M * 4 * 4;
    for (int it = gtid; it < total; it += nthreads) {
        const int q4 = it & 3, th = it >> 2, hh = 16 + (th & 3), tok = th >> 2, half = q4 >> 1, sub = q4 & 1;
        bf16* p = (hh < 16) ? q + (size_t)tok * 1024 + hh * 64 : k + (size_t)tok * 256 + (hh - 16) * 64;
        const float* gn = (hh < 16) ? qn : kn; const float osc = (hh < 16) ? attn_body::C2 : 1.0f;
        bf16* p2;
        if (hh < 16) { p += 32 * half + 8 * sub; p2 = p + 16; }
        else { const int kvh = hh - 16, bb = tok >> 13, sq = tok & 8191, tt = sq >> 6, rr = sq & 63;
               bf16* kb = k + ((size_t)(bb * 4 + kvh) * 128 + tt) * 4096 + rr * 8; p = kb + (4 * half + sub) * 512; p2 = kb + (4 * half + sub + 2) * 512; }
        const v4u w1 = *(const v4u*)p, w2 = *(const v4u*)p2;
        float x1[8], x2[8];
        x1[0] = __uint_as_float(w1.x << 16); x1[1] = __uint_as_float(w1.x & 0xffff0000u); x1[2] = __uint_as_float(w1.y << 16); x1[3] = __uint_as_float(w1.y & 0xffff0000u);
        x1[4] = __uint_as_float(w1.z << 16); x1[5] = __uint_as_float(w1.z & 0xffff0000u); x1[6] = __uint_as_float(w1.w << 16); x1[7] = __uint_as_float(w1.w & 0xffff0000u);
        x2[0] = __uint_as_float(w2.x << 16); x2[1] = __uint_as_float(w2.x & 0xffff0000u); x2[2] = __uint_as_float(w2.y << 16); x2[3] = __uint_as_float(w2.y & 0xffff0000u);
        x2[4] = __uint_as_float(w2.z << 16); x2[5] = __uint_as_float(w2.z & 0xffff0000u); x2[6] = __uint_as_float(w2.w << 16); x2[7] = __uint_as_float(w2.w & 0xffff0000u);
        float ss = 0.f;
#pragma unroll
        for (int i = 0; i < 8; ++i) ss += x1[i] * x1[i] + x2[i] * x2[i];
        ss += __shfl_xor(ss, 1); ss += __shfl_xor(ss, 2);
        const float rs = __builtin_amdgcn_rsqf(ss * (1.0f / 64.0f) + RMS_EPS);
        const int s = tok & (SEQ - 1); const float pos = (float)(half ? (s & 63) : (s >> 6));
        float o1[8], o2[8];
#pragma unroll
        for (int i = 0; i < 8; ++i) { const int ii = 8 * sub + i; const float inv = exp2f(-(float)ii * 0.83048202372184f);
            const float ang = pos * inv, c = __cosf(ang), sn = __sinf(ang);
            const float a = x1[i] * rs * gn[32 * half + ii], b = x2[i] * rs * gn[32 * half + 16 + ii];
            o1[i] = (a * c - b * sn) * osc; o2[i] = (b * c + a * sn) * osc; }
        v4u r1, r2; r1.x = pk2(o1[0], o1[1]); r1.y = pk2(o1[2], o1[3]); r1.z = pk2(o1[4], o1[5]); r1.w = pk2(o1[6], o1[7]);
        r2.x = pk2(o2[0], o2[1]); r2.y = pk2(o2[2], o2[3]); r2.z = pk2(o2[4], o2[5]); r2.w = pk2(o2[6], o2[7]);
        *(v4u*)p = r1; *(v4u*)p2 = r2;
    }
}
constexpr int RL = 128, NCH = SEQ / RL, XCF_STRIDE = 68, XCB_STRIDE = 72, NIT = BATCH * NCH * 16;
constexpr int RNN_XCF = 0, RNN_XCB = RL * XCF_STRIDE * 4, RNN_HS = RNN_XCB + RL * XCB_STRIDE * 2;
__device__ __forceinline__ void rnn_carry(const float* Pb, const float* Eb, float* CIN, int gtid, int nthreads) {
    for (int sq = gtid; sq < BATCH * 2 * 1024; sq += nthreads) {
        const int ch = sq & 1023, d = (sq >> 10) & 1, b = sq >> 11; float carry = 0.f;
        for (int k0 = 0; k0 < NCH; k0 += 8) { float pv[8], ev[8];
#pragma unroll
            for (int u = 0; u < 8; ++u) { const int jj = d ? NCH - 1 - (k0 + u) : k0 + u; const size_t ix = ((size_t)(b * NCH + jj) * 2 + d) * 1024 + ch; pv[u] = Pb[ix]; ev[u] = Eb[ix]; }
#pragma unroll
            for (int u = 0; u < 8; ++u) { const int jj = d ? NCH - 1 - (k0 + u) : k0 + u; const size_t ix = ((size_t)(b * NCH + jj) * 2 + d) * 1024 + ch; CIN[ix] = carry; carry = pv[u] * carry + ev[u]; } }
    }
}
#define RNN_LOAD_XR(IT, DST) do { const int n_ = (IT) & 15, j_ = ((IT) >> 4) & (NCH - 1), b_ = (IT) >> 10; const int s0_ = j_ * RL + tr * 16 - 2; \
        const bf16* src_ = xr + (size_t)b_ * SEQ * 1024 + 64 * n_ + c; \
        _Pragma("unroll") for (int k_ = 0; k_ < 19; ++k_) { const int s_ = s0_ + k_; DST[k_] = (s_ >= 0 && s_ < SEQ) ? src_[(size_t)s_ * 1024] : (unsigned short)0; } } while (0)
template <int PASS> __device__ __forceinline__ void rnn_pass(LAS unsigned char* lds, const bf16* xr, bf16* yr, bf16* yout, float* Pb, float* Eb, const float* CIN, const float* conv_w, const float* conv_b,
        const float* wa, const float* ba, const float* wx, const float* bxp, const float* lam, int bxid, int G) {
    const int tid = otid(), lane = tid & 63, wid = __builtin_amdgcn_readfirstlane(tid >> 6), d = wid & 1, cs = wid >> 1, fr = lane & 15, fq = lane >> 4;
    const int c = tid & 63, tr = tid >> 6;
    LAS float* XCF = (LAS float*)(lds + RNN_XCF); LAS unsigned short* XCB = (LAS unsigned short*)(lds + RNN_XCB); LAS float* HS = (LAS float*)(lds + RNN_HS);
    const int o = d ? 3 - fq : fq, tot_lane = fr + (d ? 0 : 48);
    int n_cur = -1; bf16x8 bwa[2], bwx[2]; float bav = 0.f, bxv = 0.f, sp8 = 0.f;
    bwa[0] = bwa[1] = bwx[0] = bwx[1] = (bf16x8){0, 0, 0, 0, 0, 0, 0, 0};
    unsigned short xcur[19], xnxt[19];
    if (bxid < NIT) RNN_LOAD_XR(bxid, xcur);
    for (int it = bxid; it < NIT; it += G) {
        const int n = it & 15, j = (it >> 4) & (NCH - 1), b = it >> 10;
        if (it + G < NIT) RNN_LOAD_XR(it + G, xnxt);
        {
            const int chc = 64 * n + c;
            const float cw0 = conv_w[chc], cw1 = conv_w[1024 + chc], cw2 = conv_w[2048 + chc], cw3 = conv_w[3072 + chc], cb = conv_b[chc];
#pragma unroll
            for (int k = 0; k < 16; ++k) { const float xc = cb + cw0 * bf2f(xcur[k]) + cw1 * bf2f(xcur[k + 1]) + cw2 * bf2f(xcur[k + 2]) + cw3 * bf2f(xcur[k + 3]);
                XCF[(tr * 16 + k) * XCF_STRIDE + c] = xc; XCB[(tr * 16 + k) * XCB_STRIDE + c] = (unsigned short)f2bf(xc); }
        }
        const int ch = 64 * n + 16 * cs + fr;
        if (n != n_cur) { n_cur = n;
            const float* wap = wa + ((size_t)(d * 16 + n) * 64) * 64 + 16 * cs + fr; const float* wxp = wx + ((size_t)(d * 16 + n) * 64) * 64 + 16 * cs + fr;
#pragma unroll
            for (int s = 0; s < 2; ++s)
#pragma unroll
                for (int jj = 0; jj < 8; ++jj) { const int kk = 32 * s + 8 * fq + jj; bwa[s][jj] = (short)f2bf(wap[kk * 64]); bwx[s][jj] = (short)f2bf(wxp[kk * 64]); }
            bav = ba[d * 1024 + ch]; bxv = bxp[d * 1024 + ch]; sp8 = -8.0f * log1pf(__expf(-lam[d * 1024 + ch])); }
        float carry = 0.f, Pacc = 1.f;
        if (PASS == 3) carry = CIN[((size_t)(b * NCH + j) * 2 + d) * 1024 + ch];
        v4u gy[2] = {(v4u){0u, 0u, 0u, 0u}, (v4u){0u, 0u, 0u, 0u}};
        if (PASS == 3) {
#pragma unroll
            for (int qq = 0; qq < 2; ++qq) { const int w = tid + NTHREADS * qq, t = w >> 3, c8 = (w & 7) * 8; gy[qq] = *(const v4u*)(yr + ((size_t)b * SEQ + j * RL + t) * 1024 + 64 * n + c8); } }
        __syncthreads();
        float av[8][4], uv[8][4], At[8], Ut[8], Ae[8], Ue[8];
#pragma unroll
        for (int tq = 0; tq < RL / 16; ++tq) {
            const int t0 = 16 * (d ? (RL / 16 - 1 - tq) : tq);
            const LAS unsigned char* ap = (const LAS unsigned char*)XCB + (t0 + fr) * (XCB_STRIDE * 2) + fq * 16;
            const bf16x8 a0 = *(const LAS bf16x8*)ap, a1 = *(const LAS bf16x8*)(ap + 64);
            f32x4 pa = (f32x4){0.f, 0.f, 0.f, 0.f}, px = (f32x4){0.f, 0.f, 0.f, 0.f};
            pa = __builtin_amdgcn_mfma_f32_16x16x32_bf16(a0, bwa[0], pa, 0, 0, 0); pa = __builtin_amdgcn_mfma_f32_16x16x32_bf16(a1, bwa[1], pa, 0, 0, 0);
            px = __builtin_amdgcn_mfma_f32_16x16x32_bf16(a0, bwx[0], px, 0, 0, 0); px = __builtin_amdgcn_mfma_f32_16x16x32_bf16(a1, bwx[1], px, 0, 0, 0);
#pragma unroll
            for (int i = 0; i < 4; ++i) { const float xc = XCF[(t0 + 4 * fq + i) * XCF_STRIDE + 16 * cs + fr];
                const float r = pg8::fsigmoid(pa[i] + bav), ig = pg8::fsigmoid(px[i] + bxv), la = sp8 * r, a = __expf(la), x2 = 2.0f * la;
                const float mm = (x2 > -0.02f) ? -x2 * (1.0f + x2 * (0.5f + x2 * (0.16666667f + x2 * 0.041666667f))) : 1.0f - a * a;
                av[tq][i] = a; uv[tq][i] = __builtin_amdgcn_sqrtf(mm) * ig * xc; }
            float A = 1.f, U = 0.f;
#pragma unroll
            for (int s = 0; s < 4; ++s) { const int i = d ? 3 - s : s; U = av[tq][i] * U + uv[tq][i]; A *= av[tq][i]; }
            { const float Ap = d ? __shfl_down(A, 16) : __shfl_up(A, 16), Up = d ? __shfl_down(U, 16) : __shfl_up(U, 16); if (o >= 1) { U = A * Up + U; A = A * Ap; } }
            { const float Ap = d ? __shfl_down(A, 32) : __shfl_up(A, 32), Up = d ? __shfl_down(U, 32) : __shfl_up(U, 32); if (o >= 2) { U = A * Up + U; A = A * Ap; } }
            At[tq] = __shfl(A, tot_lane); Ut[tq] = __shfl(U, tot_lane);
            if (PASS == 3) { float e0 = d ? __shfl_down(A, 16) : __shfl_up(A, 16), e1 = d ? __shfl_down(U, 16) : __shfl_up(U, 16); if (o == 0) { e0 = 1.f; e1 = 0.f; } Ae[tq] = e0; Ue[tq] = e1; }
        }
#pragma unroll
        for (int tq = 0; tq < RL / 16; ++tq) {
            const int t0 = 16 * (d ? (RL / 16 - 1 - tq) : tq);
            if (PASS == 3) { float h = Ae[tq] * carry + Ue[tq];
#pragma unroll
                for (int s = 0; s < 4; ++s) { const int i = d ? 3 - s : s; h = av[tq][i] * h + uv[tq][i]; HS[d * (RL * XCF_STRIDE) + (t0 + 4 * fq + i) * XCF_STRIDE + 16 * cs + fr] = h; } }
            carry = At[tq] * carry + Ut[tq]; Pacc *= At[tq];
        }
        if (PASS == 1) { if (fq == 0) { const size_t ix = ((size_t)(b * NCH + j) * 2 + d) * 1024 + ch; Pb[ix] = Pacc; Eb[ix] = carry; } }
        if (PASS == 3) {
            __syncthreads();
#pragma unroll
            for (int qq = 0; qq < 2; ++qq) { const int w = tid + NTHREADS * qq, t = w >> 3, c8 = (w & 7) * 8;
                const LAS float* h0 = HS + t * XCF_STRIDE + c8; const LAS float* h1 = h0 + RL * XCF_STRIDE;
                bf16* yp = yr + ((size_t)b * SEQ + j * RL + t) * 1024 + 64 * n + c8; const v4u g = gy[qq];
                float hv[8];
#pragma unroll
                for (int e = 0; e < 8; ++e) hv[e] = h0[e] + h1[e];
                v4u ov; ov.x = pk2(hv[0] * pg8::bf_lo(g.x), hv[1] * pg8::bf_hi(g.x)); ov.y = pk2(hv[2] * pg8::bf_lo(g.y), hv[3] * pg8::bf_hi(g.y));
                ov.z = pk2(hv[4] * pg8::bf_lo(g.z), hv[5] * pg8::bf_hi(g.z)); ov.w = pk2(hv[6] * pg8::bf_lo(g.w), hv[7] * pg8::bf_hi(g.w));
                *(v4u*)(yout + (yp - yr)) = ov; }
        }
        __syncthreads();
#pragma unroll
        for (int k = 0; k < 19; ++k) xcur[k] = xnxt[k];
    }
}

#define XB_TMO      128
#define XB_XCNT(j)  (256  + 64 * (j))
#define XB_XSUB(j)  (1280 + 64 * (j))
#define XB_XGEN(j)  (2304 + 64 * (j))
#define XB_TOP      3328
#define XB_TOPGEN   3392
#define XCD_BAR_WORDS 3456
#define XB_SPIN_CAP (1u << 18)

__device__ __forceinline__ unsigned xb_ld(unsigned* p)              { return __hip_atomic_load(p, __ATOMIC_RELAXED, __HIP_MEMORY_SCOPE_AGENT); }
__device__ __forceinline__ unsigned xb_add(unsigned* p, unsigned v) { return __hip_atomic_fetch_add(p, v, __ATOMIC_RELAXED, __HIP_MEMORY_SCOPE_AGENT); }
__device__ __forceinline__ unsigned xb_xcc_id() { return (unsigned)__builtin_amdgcn_s_getreg((3 << 11) | 20) & 0xFu; }
#define XB_SPIN(cond, bar) do { unsigned _sp = 0; while (cond) { __builtin_amdgcn_s_sleep(1); \
    if ((++_sp & 255u) == 0u) { if (xb_ld(&(bar)[XB_TMO])) break; if (_sp > XB_SPIN_CAP) { atomicAdd(&(bar)[XB_TMO], 1u); break; } } } } while (0)

struct XcdBarrier {
    unsigned* bar; unsigned x;
    volatile LAS unsigned* st;
};

__device__ __forceinline__ XcdBarrier xcd_barrier_post(unsigned* bar, volatile LAS unsigned* st) {
    XcdBarrier b; b.bar = bar; b.x = xb_xcc_id(); b.st = st;
    if (threadIdx.x == 0) { const unsigned r = xb_add(&bar[XB_XCNT(b.x)], 1u); st[2] = r; st[3] = b.x; }
    return b;
}
__device__ __forceinline__ void xcd_barrier_complete(unsigned* bar, unsigned x, unsigned& nloc, unsigned& nx) {
    const unsigned G = gridDim.x * gridDim.y * gridDim.z;
    unsigned sum, cnt, mine, sp = 0u;
    for (;;) {
        sum = 0u; cnt = 0u; mine = 0u;
#pragma unroll
        for (unsigned j = 0; j < 16; ++j) { const unsigned c = xb_ld(&bar[XB_XCNT(j)]); sum += c; cnt += (c > 0u) ? 1u : 0u; mine = (j == x) ? c : mine; }
        if (sum == G) break;
        __builtin_amdgcn_s_sleep(1);
        if ((++sp & 255u) == 0u) { if (xb_ld(&bar[XB_TMO])) break; if (sp > XB_SPIN_CAP) { atomicAdd(&bar[XB_TMO], 1u); break; } }
    }
    nloc = mine > 0u ? mine : 1u; nx = cnt > 0u ? cnt : 1u;
}

__device__ __forceinline__ void xcd_barrier(const XcdBarrier& b) {
    asm volatile("s_waitcnt vmcnt(0)" ::: "memory");
    __syncthreads();
    if (threadIdx.x == 0) {
        unsigned* bar = b.bar;
        __builtin_amdgcn_s_waitcnt(0);
        unsigned nloc = b.st[0], nx = b.st[1];
        if (nloc == 0u) { xcd_barrier_complete(bar, b.x, nloc, nx); b.st[0] = nloc; b.st[1] = nx; }
        const unsigned old = xb_add(&bar[XB_XSUB(b.x)], 1u);
        const unsigned gen = old / nloc;
        if (old + 1u == (gen + 1u) * nloc) {
            __builtin_amdgcn_fence(__ATOMIC_RELEASE, "agent");
            asm volatile("s_waitcnt vmcnt(0)" ::: "memory");
            const unsigned og = xb_add(&bar[XB_TOP], 1u);
            const unsigned tg = og / nx;
            if (og + 1u == (tg + 1u) * nx) xb_add(&bar[XB_TOPGEN], 1u);
            else XB_SPIN(xb_ld(&bar[XB_TOPGEN]) == tg, bar);
            __builtin_amdgcn_fence(__ATOMIC_ACQUIRE, "agent");
            xb_add(&bar[XB_XGEN(b.x)], 1u);
            asm volatile("s_waitcnt vmcnt(0)" ::: "memory");
        } else {
            XB_SPIN(xb_ld(&bar[XB_XGEN(b.x)]) == gen, bar);
            __builtin_amdgcn_fence(__ATOMIC_ACQUIRE, "agent");
            asm volatile("s_waitcnt vmcnt(0)" ::: "memory");
        }
    }
    __syncthreads();
}

#define CG_SYNC() do { asm volatile("s_waitcnt vmcnt(0) lgkmcnt(0)" ::: "memory"); grid.sync(); __builtin_amdgcn_fence(__ATOMIC_ACQUIRE, "agent"); asm volatile("s_waitcnt vmcnt(0)" ::: "memory"); } while (0)
#define GRID_SYNC() do { asm volatile("s_waitcnt lgkmcnt(0)" ::: "memory"); xcd_barrier(xbar); } while (0)
__global__ void __launch_bounds__(NTHREADS, 2) mega_fwd(Params p) {
    extern __shared__ __attribute__((aligned(16))) unsigned char lds_raw[];
    cg::grid_group grid = cg::this_grid();
    LAS unsigned char* lds = (LAS unsigned char*)lds_raw;
    const int G = gridDim.x, bx = blockIdx.x;
    volatile LAS unsigned* bst = (volatile LAS unsigned*)(lds + 131072 + 64);
    if (threadIdx.x < 2) bst[threadIdx.x] = 0u;
    __syncthreads();
    const XcdBarrier xbar = xcd_barrier_post((unsigned*)(p.ws + WS_BAR), bst);
    unsigned char* ws = p.ws;
    float* rowss = (float*)(ws + WS_ROWSS);
    bf16* XB = (bf16*)(ws + WS_XB); bf16* QB = (bf16*)(ws + WS_Q); bf16* KB = (bf16*)(ws + WS_K); bf16* VB = (bf16*)(ws + WS_V);
    bf16* XR = (bf16*)(ws + WS_XR); bf16* YR = (bf16*)(ws + WS_YR); bf16* GL = (bf16*)(ws + WS_GL); bf16* HID = (bf16*)(ws + WS_HID); bf16* MERGED = XR;
    float* Pb = (float*)(ws + WS_P); float* Eb = (float*)(ws + WS_E); float* CINb = (float*)(ws + WS_CIN);
#define PH_IDS() const int tid = otid(), lane = tid & 63, wave = __builtin_amdgcn_readfirstlane(tid >> 6), gw = bx * NWAVES + wave, ngw = G * NWAVES; LAS float* scr = (LAS float*)(lds + wave * 16384); (void)lane; (void)gw; (void)ngw; (void)scr

    { PH_IDS();
      convert_group1(p, 0, scr, gw, ngw, lane);
      convert_group2(p, 0, scr, gw, ngw, lane);
      convert_group2(p, 1, scr, gw, ngw, lane);
      x_rows(p.in[I_X], XB, rowss, gw, ngw, lane);
      (void)tid; }
    GRID_SYNC();
    if (p.ws == nullptr) CG_SYNC();
    int vbx_ = bx;
    { unsigned ok = (G % 8 == 0) ? 1u : 0u, nz = 0u, slot = 0u; const unsigned myx = bst[3], rank = bst[2]; unsigned* barw = (unsigned*)(p.ws + WS_BAR);
#pragma unroll
      for (unsigned j = 0; j < 16; ++j) { const unsigned c = xb_ld(&barw[XB_XCNT(j)]); if (c) { if (c != (unsigned)G / 8u) ok = 0u; if (j < myx) ++slot; ++nz; } }
      if (nz != 8u) ok = 0u;
      if (ok) vbx_ = (int)(rank * 8u + slot); }
    const int vbx = __builtin_amdgcn_readfirstlane(vbx_);

#pragma unroll 1
    for (int l = 0; l < NLAYER; ++l) {
        unsigned char* g2 = ws + WS_G2 + (size_t)l * G2_STRIDE;
        float* rs_ffn1 = rowss + (size_t)(3 * l + 0) * M * 16; float* rs_mix = rowss + (size_t)(3 * l + 1) * M * 16; float* rs_ffn2 = rowss + (size_t)(3 * l + 2) * M * 16;
        { pg8::Gemm g{XB, (const bf16*)(ws + WS_W1A), M, NIN, DM}; pg8::StaticOrder S; S.init(M, NIN, G, vbx);
          pg8::EpiSwiglu E{HID, rs_ffn1, DFF}; pg8::gemm_phase<pg8::EpiSwiglu, pg8::StaticOrder, true, true>(lds, g, S, E); }
        GRID_SYNC();
        { pg8::Gemm g{HID, (const bf16*)(ws + WS_W2A), M, DM, DFF}; pg8::StaticOrder S; S.init(M, DM, G, vbx);
          pg8::EpiResid E{XB, nullptr, rs_mix, 0.5f}; pg8::gemm_phase<pg8::EpiResid, pg8::StaticOrder, true, true, true>(lds, g, S, E); }
        GRID_SYNC();
        { pg8::Gemm g{XB, (const bf16*)(ws + WS_WIN), M, NIN, DM}; pg8::StaticOrder S; S.init(M, NIN, G, vbx);
          pg8::EpiIn E{QB, KB, VB, XR, YR, GL, rs_mix, p.in[I_BGATE] + l * 2048}; pg8::gemm_phase<pg8::EpiIn, pg8::StaticOrder, true, true>(lds, g, S, E); }
        GRID_SYNC();
        { PH_IDS(); qk_rope(QB, KB, p.in[I_QN] + l * 64, p.in[I_KN] + l * 64, bx * NTHREADS + tid, G * NTHREADS); }
        rnn_pass<1>(lds, XR, YR, YR, Pb, Eb, CINb, p.in[I_CONVW] + l * 4096, p.in[I_CONVB] + l * 1024, p.in[I_WA] + (size_t)l * 131072, p.in[I_BA] + l * 2048,
                    p.in[I_WX] + (size_t)l * 131072, p.in[I_BX] + l * 2048, p.in[I_LAM] + l * 2048, vbx, G);
        if (l + 1 < NLAYER) { PH_IDS(); convert_group1(p, l + 1, scr, gw, ngw, lane); }
        GRID_SYNC();
        { PH_IDS(); rnn_carry(Pb, Eb, CINb, bx * NTHREADS + tid, G * NTHREADS); }
        GRID_SYNC();
        {
            const int nun = BATCH * 16 * 32;
            bool nomax;
            { const int l64 = otid() & 63; float gq = __builtin_fabsf(p.in[I_QN][l * 64 + l64]), gk = __builtin_fabsf(p.in[I_KN][l * 64 + l64]);
#pragma unroll
              for (int o = 1; o < 64; o <<= 1) { gq = __builtin_fmaxf(gq, __shfl_xor(gq, o)); gk = __builtin_fmaxf(gk, __shfl_xor(gk, o)); }
              nomax = __builtin_amdgcn_readfirstlane((11.6f * gq * gk <= 64.0f) ? 1 : 0) != 0; }
            for (int i = 0; i * G + vbx < nun; ++i) {
                int b, h, qb;
                if (G == 256) { const int xcd = vbx & 7, idx = vbx >> 3, pair = xcd * 2 + (i >> 2); b = pair >> 2; h = (pair & 3) * 4 + (i & 3); qb = idx; }
                else { const int uid = i * G + vbx; qb = uid & 31; h = (uid >> 5) & 15; b = uid >> 9; }
                if (nomax) attn_body::attn_unit<8, true>(b, h, qb, (const attn_body::bf16*)QB, (const attn_body::bf16*)KB, (const attn_body::bf16*)VB, (attn_body::bf16*)QB, (char*)lds_raw, p.in[I_QN] + l * 64);
                else attn_body::attn_unit<8, false>(b, h, qb, (const attn_body::bf16*)QB, (const attn_body::bf16*)KB, (const attn_body::bf16*)VB, (attn_body::bf16*)QB, (char*)lds_raw, p.in[I_QN] + l * 64);
            }
            __syncthreads();
        }
        rnn_pass<3>(lds, XR, YR, YR, Pb, Eb, CINb, p.in[I_CONVW] + l * 4096, p.in[I_CONVB] + l * 1024, p.in[I_WA] + (size_t)l * 131072, p.in[I_BA] + l * 2048,
                    p.in[I_WX] + (size_t)l * 131072, p.in[I_BX] + l * 2048, p.in[I_LAM] + l * 2048, vbx, G);
        GRID_SYNC();
        { pg8::Gemm g{QB, (const bf16*)(g2 + G2_WAO), M, DM, DM}; pg8::StaticOrder S; S.init(M, DM, G, vbx);
          pg8::EpiGate<false> E{MERGED, GL, 0}; pg8::gemm_phase<pg8::EpiGate<false>, pg8::StaticOrder, true, true>(lds, g, S, E); }
        { pg8::Gemm g{YR, (const bf16*)(g2 + G2_WRO), M, DM, DM}; pg8::StaticOrder S; S.init(M, DM, G, vbx);
          pg8::EpiGate<true> E{MERGED, GL, 1024}; pg8::gemm_phase<pg8::EpiGate<true>, pg8::StaticOrder, true, true>(lds, g, S, E); }
        GRID_SYNC();
        { pg8::Gemm g{MERGED, (const bf16*)(g2 + G2_WOUT), M, DM, DM}; pg8::StaticOrder S; S.init(M, DM, G, vbx);
          pg8::EpiResid E{XB, nullptr, rs_ffn2, 1.0f}; pg8::gemm_phase<pg8::EpiResid, pg8::StaticOrder, true, true>(lds, g, S, E); }
        GRID_SYNC();
        { pg8::Gemm g{XB, (const bf16*)(g2 + G2_W1B), M, NIN, DM}; pg8::StaticOrder S; S.init(M, NIN, G, vbx);
          pg8::EpiSwiglu E{HID, rs_ffn2, DFF}; pg8::gemm_phase<pg8::EpiSwiglu, pg8::StaticOrder, true, true>(lds, g, S, E); }
        GRID_SYNC();
        { pg8::Gemm g{HID, (const bf16*)(g2 + G2_W2B), M, DM, DFF}; pg8::StaticOrder S; S.init(M, DM, G, vbx);
          const bool lastl = (l + 1 == NLAYER);
          pg8::EpiResid E{XB, lastl ? p.out : nullptr, lastl ? nullptr : rowss + (size_t)(3 * (l + 1)) * M * 16, 0.5f}; pg8::gemm_phase<pg8::EpiResid, pg8::StaticOrder, true, true, true>(lds, g, S, E); }
        if (l + 1 < NLAYER) GRID_SYNC();
    }
}

extern "C" void kernel_launch(void* const* d_in, const int* in_sizes, int n_in, void* d_out, int out_size, void* d_ws, size_t ws_size, hipStream_t stream) {
    static int grid = 0;
    if (grid == 0) {
        if (n_in != 22 || out_size != M * DM || ws_size < WS_END) { fprintf(stderr, "kernel_launch: unexpected shapes (n_in %d out %d ws %zu)\n", n_in, out_size, ws_size); grid = -1; return; }
        int dev = 0, cus = 0, per_cu = 0;
        hipGetDevice(&dev); hipDeviceGetAttribute(&cus, hipDeviceAttributeMultiprocessorCount, dev);
        hipFuncSetAttribute((const void*)mega_fwd, hipFuncAttributeMaxDynamicSharedMemorySize, LDS_BYTES);
        hipOccupancyMaxActiveBlocksPerMultiprocessor(&per_cu, (const void*)mega_fwd, NTHREADS, LDS_BYTES);
        if (per_cu < 1) { fprintf(stderr, "kernel_launch: occupancy query says %d blocks per CU\n", per_cu); per_cu = 1; }
        (void)hipGetLastError();
        grid = cus;
    }
    if (grid < 0) return;
    if (hipMemsetAsync((char*)d_ws + WS_BAR, 0, WS_BAR_BYTES, stream) != hipSuccess) { fprintf(stderr, "kernel_launch: memset of the barrier words failed\n"); return; }
    Params p{};
    for (int i = 0; i < 22; ++i) p.in[i] = (const float*)d_in[i];
    p.out = (float*)d_out; p.ws = (unsigned char*)d_ws;
    void* args[] = {&p};
    hipError_t e = hipLaunchCooperativeKernel((const void*)mega_fwd, dim3(grid), dim3(NTHREADS), args, LDS_BYTES, stream);
    if (e != hipSuccess) fprintf(stderr, "cooperative launch failed: %s (grid %d)\n", hipGetErrorString(e), grid);
}
```
